# Optimizing an MI355X kernel written in HIP

```python
import jax, jax.numpy as jnp
from jax import lax
import numpy as np

D_MODEL = 2048
BATCH = 8
SEQ = 4096
DEPTH = 1

N_META = 16
POOL_WINDOWS = (2, 4, 8, 16)
N_POOL_GROUPS = 4
POOL_WIDTH = D_MODEL // 2
POOL_GROUP_DIM = POOL_WIDTH // N_POOL_GROUPS
N_HEADS = 16
HEAD_DIM = (D_MODEL // 2) // N_HEADS
ATTN_WIDTH = N_HEADS * HEAD_DIM
ROT_DIM = HEAD_DIM // 4
ROPE_THETA = 500000.0
N_IDX_HEADS = 16
IDX_DIM = 64
IDX_ROT_DIM = IDX_DIM // 4
TOPK_KEYS_MAX = 256
Q_BLOCK = 128
N_EXPERTS = 32
TOP_K = 4
D_FF = D_MODEL
SWIGLU_LIMIT = 7.0
SWIGLU_ALPHA = 1.702
MOE_BLOCK = 512
EPS = 1e-5
IN_WIDTHS = (POOL_WIDTH, ATTN_WIDTH, ATTN_WIDTH, ATTN_WIDTH, N_IDX_HEADS * IDX_DIM, IDX_DIM, N_IDX_HEADS, D_MODEL, D_MODEL)
D_IN = sum(IN_WIDTHS)

kernel_name = "hybrid_pool_dsa_gated_moe_block"


def rms_norm(x, g):
    xf = x.astype(jnp.float32)
    y = xf * lax.rsqrt(jnp.mean(xf * xf, axis=-1, keepdims=True) + EPS)
    return (y * g.astype(jnp.float32)).astype(x.dtype)


def partial_rope(t, pos, rot_dim):
    half = rot_dim // 2
    freqs = ROPE_THETA ** (-jnp.arange(0, rot_dim, 2, dtype=jnp.float32) / rot_dim)
    ang = pos.astype(jnp.float32)[:, None] * freqs[None, :]
    cos = jnp.cos(ang)[None, :, None, :]
    sin = jnp.sin(ang)[None, :, None, :]
    x1 = t[..., :half].astype(jnp.float32)
    x2 = t[..., half:rot_dim].astype(jnp.float32)
    rot = jnp.concatenate([x1 * cos - x2 * sin, x2 * cos + x1 * sin], axis=-1).astype(t.dtype)
    return jnp.concatenate([rot, t[..., rot_dim:]], axis=-1)


def split_columns(proj):
    offs = []
    acc = 0
    for w in IN_WIDTHS[:-1]:
        acc += w
        offs.append(acc)
    return jnp.split(proj, offs, axis=-1)


def multiscale_pool(u, pool_w, pool_scale):
    B, L, _ = u.shape
    ug = u.reshape(B, L, N_POOL_GROUPS, POOL_GROUP_DIM)
    c0 = jnp.concatenate([jnp.zeros((B, 1, N_POOL_GROUPS, POOL_GROUP_DIM), jnp.float32),
                          jnp.cumsum(ug.astype(jnp.float32), axis=1)], axis=1)
    t = jnp.arange(L)
    outs = []
    for g, w in enumerate(POOL_WINDOWS):
        c = c0[:, :, g]
        lower = jnp.concatenate([jnp.zeros((B, w - 1, POOL_GROUP_DIM), jnp.float32), c[:, :L - w + 1]], axis=1)
        count = jnp.minimum(t + 1, w).astype(jnp.float32)[None, :, None]
        outs.append((c[:, 1:] - lower) / count)
    pooled = jnp.stack(outs, axis=2).astype(u.dtype) - ug
    mixed = jnp.einsum('blgc,gcd->blgd', pooled, pool_w)
    return mixed.reshape(B, L, POOL_WIDTH) * pool_scale


def indexed_sparse_attention(q, k, v, iq, ik, iw):
    B, L, _ = q.shape
    pos = jnp.arange(L)
    q = partial_rope(q.reshape(B, L, N_HEADS, HEAD_DIM), pos, ROT_DIM)
    k = partial_rope(k.reshape(B, L, N_HEADS, HEAD_DIM), pos, ROT_DIM)
    v = v.reshape(B, L, N_HEADS, HEAD_DIM)
    iq = partial_rope(iq.reshape(B, L, N_IDX_HEADS, IDX_DIM), pos, IDX_ROT_DIM)
    ik = partial_rope(ik[:, :, None, :], pos, IDX_ROT_DIM)[:, :, 0]
    iw = iw * (N_IDX_HEADS ** -0.5)
    n_sel = min(TOPK_KEYS_MAX, L // 4)
    n_blocks = -(-L // Q_BLOCK)
    l_pad = n_blocks * Q_BLOCK
    q_p = jnp.pad(q, ((0, 0), (0, l_pad - L), (0, 0), (0, 0)))
    iq_p = jnp.pad(iq, ((0, 0), (0, l_pad - L), (0, 0), (0, 0)))
    iw_p = jnp.pad(iw, ((0, 0), (0, l_pad - L), (0, 0)))
    ik_f = ik.astype(jnp.float32)
    key_pos = jnp.arange(L)

    def attend_block(b):
        start = b * Q_BLOCK
        qb = lax.dynamic_slice_in_dim(q_p, start, Q_BLOCK, axis=1)
        iqb = lax.dynamic_slice_in_dim(iq_p, start, Q_BLOCK, axis=1)
        iwb = lax.dynamic_slice_in_dim(iw_p, start, Q_BLOCK, axis=1)
        q_pos = start + jnp.arange(Q_BLOCK)
        causal = key_pos[None, :] <= q_pos[:, None]
        idx_logits = jnp.einsum('bqhd,bsd->bqhs', iqb.astype(jnp.float32), ik_f) * (IDX_DIM ** -0.5)
        score = jnp.einsum('bqhs,bqh->bqs', jax.nn.relu(idx_logits), iwb.astype(jnp.float32))
        score = jnp.where(causal[None], score, -jnp.inf)
        _, sel = lax.top_k(score, n_sel)
        valid = sel <= q_pos[None, :, None]
        k_sel = jax.vmap(lambda kk, ii: kk[ii])(k, sel)
        v_sel = jax.vmap(lambda vv, ii: vv[ii])(v, sel)
        s = jnp.einsum('bqhd,bqkhd->bqhk', qb, k_sel).astype(jnp.float32) * (HEAD_DIM ** -0.5)
        s = jnp.where(valid[:, :, None, :], s, -jnp.inf)
        p = jax.nn.softmax(s, axis=-1).astype(v.dtype)
        return jnp.einsum('bqhk,bqkhd->bqhd', p, v_sel)

    o = lax.map(attend_block, jnp.arange(n_blocks))
    o = jnp.moveaxis(o, 0, 1).reshape(B, l_pad, ATTN_WIDTH)
    return o[:, :L]


def gated_hybrid_mixer(xn, w_in, pool_w, pool_scale, w_branch_pool, w_branch_attn, w_out):
    proj = jnp.einsum('bld,de->ble', xn, w_in)
    u, q, k, v, iq, ik, iw, g_pool, g_attn = split_columns(proj)
    y_pool = jnp.einsum('blc,cd->bld', multiscale_pool(u, pool_w, pool_scale), w_branch_pool)
    y_attn = jnp.einsum('blc,cd->bld', indexed_sparse_attention(q, k, v, iq, ik, iw), w_branch_attn)
    merged = jax.nn.sigmoid(g_pool) * y_pool + jax.nn.sigmoid(g_attn) * y_attn
    return jnp.einsum('bld,de->ble', merged, w_out)


def moe_ffn(xn, router_w, router_b, w_gate, b_gate, w_up, b_up, w_down, b_down):
    B, L, D = xn.shape
    T = B * L
    xt = xn.reshape(T, D)
    logits = jnp.einsum('td,de->te', xt.astype(jnp.float32), router_w.astype(jnp.float32)) + router_b.astype(jnp.float32)
    top_val, top_idx = lax.top_k(logits, TOP_K)
    gates = jax.nn.softmax(top_val, axis=-1)
    n_assign = T * TOP_K
    flat_e = top_idx.reshape(n_assign).astype(jnp.int32)
    flat_tok = jnp.repeat(jnp.arange(T, dtype=jnp.int32), TOP_K)
    flat_gate = gates.reshape(n_assign)
    order = jnp.argsort(flat_e, stable=True)
    sorted_e = flat_e[order]
    counts = jnp.bincount(flat_e, length=N_EXPERTS).astype(jnp.int32)
    padded = ((counts + MOE_BLOCK - 1) // MOE_BLOCK) * MOE_BLOCK
    start = jnp.cumsum(counts) - counts
    pad_end = jnp.cumsum(padded)
    pad_start = pad_end - padded
    rank = jnp.arange(n_assign, dtype=jnp.int32) - start[sorted_e]
    dest = pad_start[sorted_e] + rank
    n_blocks = -(-(n_assign + N_EXPERTS * (MOE_BLOCK - 1)) // MOE_BLOCK)
    n_rows = n_blocks * MOE_BLOCK
    row_tok = jnp.full((n_rows,), T, jnp.int32).at[dest].set(flat_tok[order])
    row_gate = jnp.zeros((n_rows,), jnp.float32).at[dest].set(flat_gate[order])
    block_expert = jnp.minimum(jnp.searchsorted(pad_end, jnp.arange(n_blocks) * MOE_BLOCK, side='right'), N_EXPERTS - 1)
    x_pad = jnp.concatenate([xt, jnp.zeros((1, D), xt.dtype)], axis=0)

    def expert_block(b):
        tok = lax.dynamic_slice_in_dim(row_tok, b * MOE_BLOCK, MOE_BLOCK)
        gw = lax.dynamic_slice_in_dim(row_gate, b * MOE_BLOCK, MOE_BLOCK)
        e = block_expert[b]
        xb = x_pad[tok]
        gt = xb @ w_gate[e] + b_gate[e]
        up = xb @ w_up[e] + b_up[e]
        gt = jnp.minimum(gt, SWIGLU_LIMIT)
        up = jnp.clip(up, -SWIGLU_LIMIT, SWIGLU_LIMIT)
        hidden = (up + 1) * (gt * jax.nn.sigmoid(SWIGLU_ALPHA * gt))
        y = hidden @ w_down[e] + b_down[e]
        return y * gw[:, None].astype(y.dtype)

    rows = lax.map(expert_block, jnp.arange(n_blocks)).reshape(n_rows, D)
    out = jax.ops.segment_sum(rows, row_tok, num_segments=T + 1)[:T]
    return out.reshape(B, L, D)


def setup_inputs(seed: int = 0) -> dict:
    key = jax.random.key(seed)
    ks = jax.random.split(key, 20)
    f32 = jnp.float32
    nrm = lambda k, shape, scale: jax.random.normal(k, shape, f32) * scale
    return {
        "x": nrm(ks[0], (BATCH, SEQ, D_MODEL), 1.0),
        "meta_tokens": nrm(ks[1], (N_META, D_MODEL), 1.0),
        "norm_mix_g": 1.0 + nrm(ks[2], (DEPTH, D_MODEL), 0.02),
        "w_in": nrm(ks[3], (DEPTH, D_MODEL, D_IN), D_MODEL ** -0.5),
        "pool_w": nrm(ks[4], (DEPTH, N_POOL_GROUPS, POOL_GROUP_DIM, POOL_GROUP_DIM), POOL_GROUP_DIM ** -0.5),
        "pool_scale": 1.0 + nrm(ks[5], (DEPTH, POOL_WIDTH), 0.02),
        "w_branch_pool": nrm(ks[6], (DEPTH, POOL_WIDTH, D_MODEL), POOL_WIDTH ** -0.5),
        "w_branch_attn": nrm(ks[7], (DEPTH, ATTN_WIDTH, D_MODEL), ATTN_WIDTH ** -0.5),
        "w_out": nrm(ks[8], (DEPTH, D_MODEL, D_MODEL), D_MODEL ** -0.5),
        "norm_moe_g": 1.0 + nrm(ks[9], (DEPTH, D_MODEL), 0.02),
        "router_w": nrm(ks[10], (DEPTH, D_MODEL, N_EXPERTS), D_MODEL ** -0.5),
        "router_b": nrm(ks[11], (DEPTH, N_EXPERTS), 0.01),
        "exp_w_gate": nrm(ks[12], (DEPTH, N_EXPERTS, D_MODEL, D_FF), D_MODEL ** -0.5),
        "exp_b_gate": nrm(ks[13], (DEPTH, N_EXPERTS, D_FF), 0.02),
        "exp_w_up": nrm(ks[14], (DEPTH, N_EXPERTS, D_MODEL, D_FF), D_MODEL ** -0.5),
        "exp_b_up": nrm(ks[15], (DEPTH, N_EXPERTS, D_FF), 0.02),
        "exp_w_down": nrm(ks[16], (DEPTH, N_EXPERTS, D_FF, D_MODEL), D_FF ** -0.5),
        "exp_b_down": nrm(ks[17], (DEPTH, N_EXPERTS, D_MODEL), 0.02),
        "norm_final_g": 1.0 + nrm(ks[18], (D_MODEL,), 0.02),
    }


def reference(x, meta_tokens, norm_mix_g, w_in, pool_w, pool_scale, w_branch_pool, w_branch_attn, w_out,
              norm_moe_g, router_w, router_b, exp_w_gate, exp_b_gate, exp_w_up, exp_b_up, exp_w_down,
              exp_b_down, norm_final_g):
    B = x.shape[0]
    meta = jnp.broadcast_to(meta_tokens[None].astype(x.dtype), (B, N_META, D_MODEL))
    h = jnp.concatenate([meta, x], axis=1)
    for i in range(DEPTH):
        h = h + gated_hybrid_mixer(rms_norm(h, norm_mix_g[i]), w_in[i], pool_w[i], pool_scale[i],
                                   w_branch_pool[i], w_branch_attn[i], w_out[i])
        h = h + moe_ffn(rms_norm(h, norm_moe_g[i]), router_w[i], router_b[i], exp_w_gate[i], exp_b_gate[i],
                        exp_w_up[i], exp_b_up[i], exp_w_down[i], exp_b_down[i])
    h = rms_norm(h, norm_final_g)
    return h[:, N_META:]
```

```cpp
#include <hip/hip_runtime.h>
#include <cstdio>
#include <cstdint>

#ifndef MK_N_LAUNCHES
#define MK_N_LAUNCHES 1
#endif

#define GAS __attribute__((address_space(1)))
#define LAS __attribute__((address_space(3)))
typedef unsigned short bf16_t;
typedef short bf16x8 __attribute__((ext_vector_type(8)));
typedef short s16x4 __attribute__((ext_vector_type(4)));
typedef float f32x4 __attribute__((ext_vector_type(4)));
typedef float f32x16 __attribute__((ext_vector_type(16)));
typedef float f32x2 __attribute__((ext_vector_type(2)));
typedef __bf16 bf16x2_t __attribute__((ext_vector_type(2)));
typedef unsigned u32x4 __attribute__((ext_vector_type(4)));
typedef unsigned u32x2 __attribute__((ext_vector_type(2)));
typedef GAS unsigned gu32;

constexpr int DM = 2048, NB = 8, SEQ = 4096, NMETA = 16, LL = SEQ + NMETA;
constexpr int TROWS = NB * LL;
constexpr int MPAD = 33024;
constexpr int DIN = 9296, DINP = 9472;
constexpr int C_U = 0, C_Q = 1024, C_K = 2048, C_V = 3072, C_IQ = 4096, C_IK = 5120, C_IW = 5184, C_GP = 5200, C_GA = 7248;
constexpr int NH = 16, HD = 64, NE = 32, TOPK = 4, DFF = 2048;
constexpr int TOK2 = NB * SEQ;
constexpr int NASSIGN = TOK2 * TOPK;
constexpr int NSEL = 256;
constexpr int KPAD = 4160;
constexpr int MASKW = 66;
constexpr float EPS = 1e-5f;
constexpr float LOG2E = 1.4426950408889634f;

constexpr size_t MiB = 1u << 20;
constexpr size_t WS_CTL = 0, CTL_ZERO_BYTES = 1 * MiB;
constexpr size_t WS_ROPE = 1 * MiB;
constexpr size_t WS_ROUTE = 2 * MiB;
constexpr size_t RT_TOKE = 0, RT_TOKP = 1 * MiB, RT_LIST = 2 * MiB, RT_GLIST = 6 * MiB;
constexpr size_t WS_WIN = 12 * MiB;
constexpr size_t WS_WEFF = 49 * MiB;
constexpr size_t WS_WBA = 53 * MiB;
constexpr size_t WS_WOUT = 57 * MiB;
constexpr size_t WS_WGU = 65 * MiB;
constexpr size_t WS_Y = WS_WGU;
constexpr size_t WS_WD = 577 * MiB;
constexpr size_t WS_XN = 833 * MiB;
constexpr size_t WS_P = 962 * MiB;
constexpr size_t WS_HID = WS_P;
constexpr size_t WS_POOL = 1559 * MiB;
constexpr size_t WS_O = 1624 * MiB;
constexpr size_t WS_MG = 1689 * MiB;
constexpr size_t WS_VT = 1818 * MiB;
constexpr size_t WS_MASK = 1883 * MiB;
constexpr size_t WS_END = 1900 * MiB;
static_assert(WS_WIN + (size_t)DINP * DM * 2 <= WS_WEFF && WS_XN + (size_t)MPAD * DM * 2 <= WS_P && WS_P + (size_t)MPAD * DINP * 2 <= WS_POOL, "ws map");
static_assert(WS_HID + (size_t)(NASSIGN + 256) * DFF * 2 <= WS_POOL && WS_POOL + (size_t)MPAD * 1024 * 2 <= WS_O && WS_O + (size_t)MPAD * 1024 * 2 <= WS_MG, "ws map");
static_assert(WS_MG + (size_t)MPAD * DM * 2 <= WS_VT && WS_VT + (size_t)NB * NH * 64 * KPAD * 2 <= WS_MASK && WS_MASK + (size_t)TROWS * MASKW * 8 <= WS_END, "ws map");
static_assert(WS_WGU + (size_t)NE * 4096 * 2048 * 2 <= WS_WD && WS_WD + (size_t)NE * 2048 * 2048 * 2 <= WS_XN, "ws map");

constexpr int CW_TMO = 0;
constexpr int CW_TICKET = 64;
constexpr int CW_CURSOR = 1024;
constexpr int CW_BAR = 4096;

constexpr int RING_BYTES = 131072;
constexpr int LDSCTL_OFF = 139264;
constexpr int LDS_BYTES = 147456;
constexpr int NWAVES = 8, NTHR = 512;

#define RLX_AGENT __ATOMIC_RELAXED, __HIP_MEMORY_SCOPE_AGENT
#define LDS_WAIT() asm volatile("s_waitcnt lgkmcnt(0)" ::: "memory")
#define VM_WAIT() asm volatile("s_waitcnt vmcnt(0)" ::: "memory")

__device__ __forceinline__ unsigned f2bf(float f) { unsigned u = __builtin_bit_cast(unsigned, f); return (u + 0x7fffu + ((u >> 16) & 1u)) >> 16; }
__device__ __forceinline__ unsigned pk2(float lo, float hi) { f32x2 v = {lo, hi}; bf16x2_t b = __builtin_convertvector(v, bf16x2_t); return __builtin_bit_cast(unsigned, b); }
__device__ __forceinline__ float bf2f(unsigned short x) { return __uint_as_float(((unsigned)x) << 16); }
__device__ __forceinline__ float bflo(unsigned w) { return __uint_as_float(w << 16); }
__device__ __forceinline__ float bfhi(unsigned w) { return __uint_as_float(w & 0xffff0000u); }
__device__ __forceinline__ float sigmoidf_(float x) { return __builtin_amdgcn_rcpf(1.0f + __builtin_amdgcn_exp2f(-LOG2E * x)); }
__device__ __forceinline__ float wave_sum(float v) {
#pragma unroll
    for (int o = 1; o < 64; o <<= 1) v += __shfl_xor(v, o);
    return v;
}
__device__ __forceinline__ int wave_sum_i(int v) {
#pragma unroll
    for (int o = 1; o < 64; o <<= 1) v += __shfl_xor(v, o);
    return v;
}

#define XB_TMO      128
#define XB_XCNT(j)  (256  + 64 * (j))
#define XB_XSUB(j)  (1280 + 64 * (j))
#define XB_XGEN(j)  (2304 + 64 * (j))
#define XB_TOP      3328
#define XB_TOPGEN   3392
#define XCD_BAR_WORDS 3456
#define XB_SPIN_CAP (1u << 22)

__device__ __forceinline__ unsigned xb_ld(unsigned* p)              { return __hip_atomic_load(p, __ATOMIC_RELAXED, __HIP_MEMORY_SCOPE_AGENT); }
__device__ __forceinline__ unsigned xb_add(unsigned* p, unsigned v) { return __hip_atomic_fetch_add(p, v, __ATOMIC_RELAXED, __HIP_MEMORY_SCOPE_AGENT); }
__device__ __forceinline__ unsigned xb_xcc_id() { return (unsigned)__builtin_amdgcn_s_getreg((3 << 11) | 20) & 0xFu; }
#define XB_SPIN(cond, bar) do { unsigned _sp = 0; while (cond) { __builtin_amdgcn_s_sleep(1); \
    if ((++_sp & 255u) == 0u) { if (xb_ld(&(bar)[XB_TMO])) break; if (_sp > XB_SPIN_CAP) { atomicAdd(&(bar)[XB_TMO], 1u); break; } } } } while (0)

struct XcdBarrier { unsigned* bar; unsigned x; volatile LAS unsigned* st; };

__device__ __forceinline__ XcdBarrier xcd_barrier_post(unsigned* bar, volatile LAS unsigned* st) {
    XcdBarrier b; b.bar = bar; b.x = xb_xcc_id(); b.st = st;
    if (threadIdx.x == 0) (void)xb_add(&bar[XB_XCNT(b.x)], 1u);
    return b;
}
__device__ __forceinline__ void xcd_barrier_complete(unsigned* bar, unsigned x, unsigned& nloc, unsigned& nx) {
    const unsigned G = gridDim.x * gridDim.y * gridDim.z;
    unsigned sum, cnt, mine, sp = 0u;
    for (;;) {
        sum = 0u; cnt = 0u; mine = 0u;
#pragma unroll
        for (unsigned j = 0; j < 16; ++j) { const unsigned c = xb_ld(&bar[XB_XCNT(j)]); sum += c; cnt += (c > 0u) ? 1u : 0u; mine = (j == x) ? c : mine; }
        if (sum == G) break;
        __builtin_amdgcn_s_sleep(1);
        if ((++sp & 255u) == 0u) { if (xb_ld(&bar[XB_TMO])) break; if (sp > XB_SPIN_CAP) { atomicAdd(&bar[XB_TMO], 1u); break; } }
    }
    nloc = mine > 0u ? mine : 1u; nx = cnt > 0u ? cnt : 1u;
}
__device__ __forceinline__ void xcd_barrier(const XcdBarrier& b) {
    asm volatile("s_waitcnt vmcnt(0)" ::: "memory");
    __syncthreads();
    if (threadIdx.x == 0) {
        unsigned* bar = b.bar;
        __builtin_amdgcn_s_waitcnt(0);
        unsigned nloc = b.st[0], nx = b.st[1];
        if (nloc == 0u) { xcd_barrier_complete(bar, b.x, nloc, nx); b.st[0] = nloc; b.st[1] = nx; }
        const unsigned old = xb_add(&bar[XB_XSUB(b.x)], 1u);
        const unsigned gen = old / nloc;
        if (old + 1u == (gen + 1u) * nloc) {
            __builtin_amdgcn_fence(__ATOMIC_RELEASE, "agent");
            asm volatile("s_waitcnt vmcnt(0)" ::: "memory");
            const unsigned og = xb_add(&bar[XB_TOP], 1u);
            const unsigned tg = og / nx;
            if (og + 1u == (tg + 1u) * nx) xb_add(&bar[XB_TOPGEN], 1u);
            else XB_SPIN(xb_ld(&bar[XB_TOPGEN]) == tg, bar);
            __builtin_amdgcn_fence(__ATOMIC_ACQUIRE, "agent");
            xb_add(&bar[XB_XGEN(b.x)], 1u);
            asm volatile("s_waitcnt vmcnt(0)" ::: "memory");
        } else {
            XB_SPIN(xb_ld(&bar[XB_XGEN(b.x)]) == gen, bar);
            __builtin_amdgcn_fence(__ATOMIC_ACQUIRE, "agent");
            asm volatile("s_waitcnt vmcnt(0)" ::: "memory");
        }
    }
    __syncthreads();
}

namespace pg8 {
constexpr int BM = 256, BK = 64, HALF = 128, HTB = HALF * BK * 2, STAGE_BYTES = 8 * HTB;
__host__ __device__ __forceinline__ int lds_byte(int r, int c) { const int st = (r >> 4) * 2 + (c >> 5), rr = r & 15, cc = c & 31, ob = rr * 64 + cc * 2; return st * 1024 + (ob ^ (((ob >> 9) & 1) << 5)); }
__host__ __device__ __forceinline__ void stage_rc(int b, int& R, int& C) { const int st = b / 1024, sb = b % 1024, swz = sb ^ (((sb >> 9) & 1) << 5); R = (st >> 1) * 16 + swz / 64; C = (st & 1) * 32 + (swz % 64) / 2; }
__host__ __device__ __forceinline__ int perm32(int rho) { const int n = rho >> 4, i = rho & 15; return 8 * (i >> 2) + 4 * n + (i & 3); }

struct Unit { int pm, pn; const char* B; int e, mt, nval, slot0; };

template <class Epi, class Sched, class AMap, bool ALIGN_EPI>
__device__ __forceinline__ void gemm_phase(LAS unsigned char* lds, const char* Abase, const int K, const Sched& S, const AMap& AM, const Epi& E) {
    const int tid = threadIdx.x, wid = __builtin_amdgcn_readfirstlane(tid >> 6), lane = tid & 63, wr = wid >> 2, wc = wid & 3, fr = lane & 15, fq = lane >> 4;
    const int nt = K / BK;
    int RA[2], CA[2]; unsigned voffB[2];
#pragma unroll
    for (int i = 0; i < 2; ++i) { int R, C; stage_rc(tid * 16 + i * 8192, R, C); const int Rb = Epi::PERM ? ((R & ~31) + perm32(R & 31)) : R;
        RA[i] = R; CA[i] = C; voffB[i] = (unsigned)(Rb * K + C) * 2u; }
    const size_t kstep = (size_t)(BK * 2);
    const size_t hstep = (size_t)HALF * K * 2;
    const unsigned ldsw = (unsigned)wid * 1024u;
    const int aoff = lds_byte(wr * 64 + fr, fq * 8), boff = lds_byte(wc * 32 + fr, fq * 8);
#define PG8_SA(b, h) (((b) * 2 + (h)) * HTB)
#define PG8_SB(b, h) ((4 + (b) * 2 + (h)) * HTB)
#define PG8_STAGE(bufoff, gbase, voff) do { _Pragma("unroll") for (int _i = 0; _i < 2; ++_i) \
        __builtin_amdgcn_global_load_lds((const unsigned*)((const char*)(gbase) + (voff)[_i]), (LAS unsigned*)(lds + (bufoff) + ldsw + _i * 8192), 16, 0, 0); } while (0)
#define PG8_LDA(dst, b, h) do { _Pragma("unroll") for (int m = 0; m < 4; ++m) _Pragma("unroll") for (int k = 0; k < 2; ++k) dst[m][k] = *(const LAS bf16x8*)(lds + PG8_SA(b, h) + aoff + m * 2048 + k * 1024); } while (0)
#define PG8_LDB(dst, b, h) do { _Pragma("unroll") for (int n = 0; n < 2; ++n) _Pragma("unroll") for (int k = 0; k < 2; ++k) dst[n][k] = *(const LAS bf16x8*)(lds + PG8_SB(b, h) + boff + n * 2048 + k * 1024); } while (0)
#define PG8_MMA(ai, bj, At, Bt) do { __builtin_amdgcn_s_setprio(1); _Pragma("unroll") for (int m = 0; m < 4; ++m) _Pragma("unroll") for (int n = 0; n < 2; ++n) _Pragma("unroll") for (int k = 0; k < 2; ++k) \
        acc[ai][bj][m][n] = __builtin_amdgcn_mfma_f32_16x16x32_bf16(Bt[n][k], At[m][k], acc[ai][bj][m][n], 0, 0, 0); __builtin_amdgcn_s_setprio(0); } while (0)
#define PG8_WAIT_V(n) asm volatile("s_waitcnt vmcnt(" #n ")" ::: "memory")
#define PG8_WAIT_L(n) asm volatile("s_waitcnt lgkmcnt(" #n ")" ::: "memory")
#define PG8_BAR __builtin_amdgcn_s_barrier()
#define PG8_SCHED __builtin_amdgcn_sched_barrier(0)
    Unit cur, nxt; int ui = 0;
    if (!S.next(0, cur)) return;
    f32x4 acc[2][2][4][2];
#pragma unroll
    for (int a = 0; a < 2; ++a)
#pragma unroll
        for (int b = 0; b < 2; ++b)
#pragma unroll
            for (int m = 0; m < 4; ++m)
#pragma unroll
                for (int n = 0; n < 2; ++n) acc[a][b][m][n] = (f32x4){0.f, 0.f, 0.f, 0.f};
    bf16x8 At[4][2], B0[2][2], B1[2][2];
    unsigned cA0[2], cA1[2], nA0[2], nA1[2];
    AM.offs(cur, RA, CA, cA0, cA1);
    const char* cB = cur.B;
    PG8_STAGE(PG8_SB(0, 0), cB, voffB); PG8_STAGE(PG8_SB(0, 1), cB + hstep, voffB); PG8_STAGE(PG8_SA(0, 0), Abase, cA0); PG8_STAGE(PG8_SA(0, 1), Abase, cA1);
    if (wr == 1) PG8_BAR;
    PG8_WAIT_V(2); PG8_BAR;
    PG8_STAGE(PG8_SB(1, 0), cB + kstep, voffB); PG8_STAGE(PG8_SA(1, 0), Abase + kstep, cA0); PG8_STAGE(PG8_SB(1, 1), cB + hstep + kstep, voffB);
    PG8_WAIT_V(6); PG8_BAR;
    for (;;) {
        const bool has_next = S.next(ui + 1, nxt);
        if (has_next) AM.offs(nxt, RA, CA, nA0, nA1); else { nA0[0] = cA0[0]; nA0[1] = cA0[1]; nA1[0] = cA1[0]; nA1[1] = cA1[1]; }
        const char* nB = has_next ? nxt.B : cB;
        for (int t = 0; t < nt; t += 2) {
            const bool last = (t == nt - 2);
            const char* a1 = Abase + (size_t)(t + 1) * kstep;
            const char* a2 = last ? Abase : Abase + (size_t)(t + 2) * kstep;
            const char* b2 = last ? nB : cB + (size_t)(t + 2) * kstep;
            const char* a3 = a2 + kstep; const char* b3 = b2 + kstep;
            unsigned x0[2], x1[2];
            x0[0] = last ? nA0[0] : cA0[0]; x0[1] = last ? nA0[1] : cA0[1]; x1[0] = last ? nA1[0] : cA1[0]; x1[1] = last ? nA1[1] : cA1[1];
            PG8_LDB(B0, 0, 0); PG8_LDB(B1, 0, 1); PG8_SCHED; PG8_LDA(At, 0, 0); PG8_STAGE(PG8_SA(1, 1), a1, cA1);
            PG8_WAIT_V(8); PG8_WAIT_L(0); PG8_BAR; PG8_MMA(0, 0, At, B0); PG8_MMA(0, 1, At, B1); PG8_BAR; PG8_SCHED;
            PG8_LDA(At, 0, 1); PG8_STAGE(PG8_SB(0, 0), b2, voffB); PG8_STAGE(PG8_SB(0, 1), b2 + hstep, voffB); PG8_STAGE(PG8_SA(0, 0), a2, x0);
            PG8_WAIT_V(8); PG8_WAIT_L(0); PG8_BAR; PG8_MMA(1, 0, At, B0); PG8_MMA(1, 1, At, B1); PG8_BAR; PG8_SCHED;
            PG8_LDB(B0, 1, 0); PG8_LDB(B1, 1, 1); PG8_SCHED; PG8_LDA(At, 1, 0); PG8_STAGE(PG8_SA(0, 1), a2, x1);
            PG8_WAIT_V(8); PG8_WAIT_L(0); PG8_BAR; PG8_MMA(0, 0, At, B0); PG8_MMA(0, 1, At, B1); PG8_BAR; PG8_SCHED;
            PG8_LDA(At, 1, 1); PG8_STAGE(PG8_SB(1, 0), b3, voffB); PG8_STAGE(PG8_SB(1, 1), b3 + hstep, voffB); PG8_STAGE(PG8_SA(1, 0), a3, x0);
            PG8_WAIT_V(8); PG8_WAIT_L(0); PG8_BAR; PG8_MMA(1, 0, At, B0); PG8_MMA(1, 1, At, B1); PG8_BAR; PG8_SCHED;
        }
        if constexpr (ALIGN_EPI) { if (wr == 0) PG8_BAR; }
        E(acc, cur, wr, wc, fr, fq);
        if (!has_next) break;
#pragma unroll
        for (int a = 0; a < 2; ++a)
#pragma unroll
            for (int b = 0; b < 2; ++b)
#pragma unroll
                for (int m = 0; m < 4; ++m)
#pragma unroll
                    for (int n = 0; n < 2; ++n) acc[a][b][m][n] = (f32x4){0.f, 0.f, 0.f, 0.f};
        cur = nxt; cB = nB; cA0[0] = nA0[0]; cA0[1] = nA0[1]; cA1[0] = nA1[0]; cA1[1] = nA1[1]; ++ui;
        if constexpr (ALIGN_EPI) { if (wr == 1) PG8_BAR; }
    }
    PG8_WAIT_V(0);
    if constexpr (!ALIGN_EPI) { if (wr == 0) PG8_BAR; }
    PG8_BAR;
#undef PG8_SA
#undef PG8_SB
#undef PG8_STAGE
#undef PG8_LDA
#undef PG8_LDB
#undef PG8_MMA
#undef PG8_WAIT_V
#undef PG8_WAIT_L
#undef PG8_BAR
#undef PG8_SCHED
}

struct DenseOrder {
    int nM, nN, nwg, G, c; const char* Bt; size_t tstep;
    __device__ void init(int nM_, int nN_, int G_, int c_, const void* Bt_, int K) { nM = nM_; nN = nN_; nwg = nM * nN; G = G_; c = c_; Bt = (const char*)Bt_; tstep = (size_t)256 * K * 2; }
    __device__ __forceinline__ bool next(int i, Unit& u) const {
        const long L = (long)i * G + c; if (L >= nwg) return false;
        int wgid = (int)L; { const int q = nwg / 8, r = nwg % 8, xcd = wgid % 8, off = wgid / 8; wgid = (xcd < r ? xcd * (q + 1) : r * (q + 1) + (xcd - r) * q) + off; }
        const int nig = 8 * nN, gid = wgid / nig, fm = gid * 8, gsz = (nM - fm) < 8 ? (nM - fm) : 8;
        u.pm = fm + ((wgid % nig) % gsz); u.pn = (wgid % nig) / gsz; u.B = Bt + (size_t)u.pn * tstep; u.e = 0; u.mt = 0; u.nval = 256; u.slot0 = u.pm * 256; return true;
    }
};
struct DenseA {
    int K;
    __device__ __forceinline__ void offs(const Unit& u, const int (&RA)[2], const int (&CA)[2], unsigned (&o0)[2], unsigned (&o1)[2]) const {
#pragma unroll
        for (int i = 0; i < 2; ++i) { o0[i] = (unsigned)((u.pm * 256 + RA[i]) * K + CA[i]) * 2u; o1[i] = (unsigned)((u.pm * 256 + 128 + RA[i]) * K + CA[i]) * 2u; }
    }
};
struct MoeOrder {
    const LAS int* tp; const LAS int* cb; int NPN, G, c; const char* W; size_t estride, tstep;
    __device__ __forceinline__ bool next(int i, Unit& u) const {
#define RFL(x) __builtin_amdgcn_readfirstlane(x)
        const int L = i * G + c; const int total = RFL(tp[NE]) * NPN; if (L >= total) return false;
        int e = 0;
        while (e < NE - 1 && RFL(tp[e + 1]) * NPN <= L) ++e;
        const int tpe = RFL(tp[e]), tpe1 = RFL(tp[e + 1]), cbe = RFL(cb[e]), cbe1 = RFL(cb[e + 1]);
        const int loc = L - tpe * NPN, tl = tpe1 - tpe;
        u.e = e; u.mt = loc % tl; u.pn = loc / tl; u.pm = 0; const int cnt = cbe1 - cbe;
        const int rem = cnt - u.mt * 256; u.nval = rem < 256 ? rem : 256; u.slot0 = cbe + u.mt * 256;
        u.B = W + (size_t)e * estride + (size_t)u.pn * tstep; return true;
#undef RFL
    }
};
struct GatherA {
    const int* list; int K;
    __device__ __forceinline__ void offs(const Unit& u, const int (&RA)[2], const int (&CA)[2], unsigned (&o0)[2], unsigned (&o1)[2]) const {
#pragma unroll
        for (int i = 0; i < 2; ++i) {
            const int r0 = RA[i], r1 = 128 + RA[i];
            const int t0 = r0 < u.nval ? list[u.e * TOK2 + u.mt * 256 + r0] : 0, t1 = r1 < u.nval ? list[u.e * TOK2 + u.mt * 256 + r1] : 0;
            o0[i] = (unsigned)(t0 * K + CA[i]) * 2u; o1[i] = (unsigned)(t1 * K + CA[i]) * 2u; }
    }
};
struct SlotA {
    int K;
    __device__ __forceinline__ void offs(const Unit& u, const int (&RA)[2], const int (&CA)[2], unsigned (&o0)[2], unsigned (&o1)[2]) const {
#pragma unroll
        for (int i = 0; i < 2; ++i) { o0[i] = (unsigned)((u.slot0 + RA[i]) * K + CA[i]) * 2u; o1[i] = (unsigned)((u.slot0 + 128 + RA[i]) * K + CA[i]) * 2u; }
    }
};

struct EpiBf16 {
    static constexpr bool PERM = true;
    bf16_t* O; int ldc;
    __device__ __forceinline__ void operator()(const f32x4 (&acc)[2][2][4][2], const Unit& u, int wr, int wc, int fr, int fq) const {
        const int row0 = u.pm * BM + wr * 64 + fr, col0 = u.pn * BM + wc * 32 + 8 * fq;
#pragma unroll
        for (int ai = 0; ai < 2; ++ai)
#pragma unroll
            for (int m = 0; m < 4; ++m) { bf16_t* rowp = O + (size_t)(row0 + ai * HALF + m * 16) * ldc + col0;
#pragma unroll
                for (int bj = 0; bj < 2; ++bj) { const f32x4 v0 = acc[ai][bj][m][0], v1 = acc[ai][bj][m][1];
                    u32x4 w; w.x = pk2(v0[0], v0[1]); w.y = pk2(v0[2], v0[3]); w.z = pk2(v1[0], v1[1]); w.w = pk2(v1[2], v1[3]);
                    *(u32x4*)(rowp + bj * HALF) = w; } }
    }
};
template <bool ADD> struct EpiGate {
    static constexpr bool PERM = true;
    bf16_t* MG; const bf16_t* P; int gcol;
    __device__ __forceinline__ void operator()(const f32x4 (&acc)[2][2][4][2], const Unit& u, int wr, int wc, int fr, int fq) const {
        const int row0 = u.pm * BM + wr * 64 + fr, col0 = u.pn * BM + wc * 32 + 8 * fq;
#pragma unroll
        for (int ai = 0; ai < 2; ++ai)
#pragma unroll
            for (int m = 0; m < 4; ++m) { const size_t row = (size_t)(row0 + ai * HALF + m * 16);
#pragma unroll
                for (int bj = 0; bj < 2; ++bj) { const int col = col0 + bj * HALF;
                    const u32x4 g = *(const u32x4*)(P + row * DINP + gcol + col);
                    f32x4 v0 = acc[ai][bj][m][0], v1 = acc[ai][bj][m][1];
                    v0[0] *= sigmoidf_(bflo(g.x)); v0[1] *= sigmoidf_(bfhi(g.x)); v0[2] *= sigmoidf_(bflo(g.y)); v0[3] *= sigmoidf_(bfhi(g.y));
                    v1[0] *= sigmoidf_(bflo(g.z)); v1[1] *= sigmoidf_(bfhi(g.z)); v1[2] *= sigmoidf_(bflo(g.w)); v1[3] *= sigmoidf_(bfhi(g.w));
                    bf16_t* op = MG + row * DM + col;
                    if (ADD) { const u32x4 o = *(const u32x4*)op;
                        v0[0] += bflo(o.x); v0[1] += bfhi(o.x); v0[2] += bflo(o.y); v0[3] += bfhi(o.y); v1[0] += bflo(o.z); v1[1] += bfhi(o.z); v1[2] += bflo(o.w); v1[3] += bfhi(o.w); }
                    u32x4 w; w.x = pk2(v0[0], v0[1]); w.y = pk2(v0[2], v0[3]); w.z = pk2(v1[0], v1[1]); w.w = pk2(v1[2], v1[3]);
                    *(u32x4*)op = w; } }
    }
};
struct EpiResid {
    static constexpr bool PERM = false;
    const float* x; float* out;
    __device__ __forceinline__ void operator()(const f32x4 (&acc)[2][2][4][2], const Unit& u, int wr, int wc, int fr, int fq) const {
        const int row0 = u.pm * BM + wr * 64 + fr, col0 = u.pn * BM + wc * 32 + 4 * fq;
#pragma unroll
        for (int ai = 0; ai < 2; ++ai)
#pragma unroll
            for (int m = 0; m < 4; ++m) { const int row = row0 + ai * HALF + m * 16; const int b = row / LL, l = row - b * LL;
                if (row < TROWS && l >= NMETA) { const size_t off = (size_t)(b * SEQ + l - NMETA) * DM + col0;
#pragma unroll
                    for (int bj = 0; bj < 2; ++bj)
#pragma unroll
                        for (int n = 0; n < 2; ++n) { const f32x4 hv = *(const f32x4*)(x + off + bj * HALF + n * 16); *(f32x4*)(out + off + bj * HALF + n * 16) = acc[ai][bj][m][n] + hv; } } }
    }
};
struct EpiSwiglu {
    static constexpr bool PERM = true;
    bf16_t* HID; const float* bg; const float* bu;
    __device__ __forceinline__ void operator()(const f32x4 (&acc)[2][2][4][2], const Unit& u, int wr, int wc, int fr, int fq) const {
        const int f0 = u.pn * 128 + wc * 32 + 8 * fq;
        const f32x4 g0 = *(const f32x4*)(bg + u.e * DFF + f0), g1 = *(const f32x4*)(bg + u.e * DFF + f0 + 4), u0 = *(const f32x4*)(bu + u.e * DFF + f0), u1 = *(const f32x4*)(bu + u.e * DFF + f0 + 4);
#pragma unroll
        for (int ai = 0; ai < 2; ++ai)
#pragma unroll
            for (int m = 0; m < 4; ++m) { const int r = ai * HALF + wr * 64 + m * 16 + fr;
                if (r < u.nval) {
                    float hv[8];
#pragma unroll
                    for (int n = 0; n < 2; ++n) { const f32x4 gg = acc[ai][0][m][n] + (n ? g1 : g0), uu = acc[ai][1][m][n] + (n ? u1 : u0);
#pragma unroll
                        for (int j = 0; j < 4; ++j) { const float gt = fminf(gg[j], 7.0f), up = fminf(fmaxf(uu[j], -7.0f), 7.0f);
                            hv[4 * n + j] = (up + 1.0f) * gt * __builtin_amdgcn_rcpf(1.0f + __builtin_amdgcn_exp2f(-1.702f * LOG2E * gt)); } }
                    u32x4 w; w.x = pk2(hv[0], hv[1]); w.y = pk2(hv[2], hv[3]); w.z = pk2(hv[4], hv[5]); w.w = pk2(hv[6], hv[7]);
                    *(u32x4*)(HID + (size_t)(u.slot0 + r) * DFF + f0) = w; } }
    }
};
struct EpiDown {
    static constexpr bool PERM = true;
    bf16_t* Y; const float* bd; const float* glist;
    __device__ __forceinline__ void operator()(const f32x4 (&acc)[2][2][4][2], const Unit& u, int wr, int wc, int fr, int fq) const {
        const int col0 = u.pn * BM + wc * 32 + 8 * fq;
        f32x4 bv[2][2];
#pragma unroll
        for (int bj = 0; bj < 2; ++bj)
#pragma unroll
            for (int n = 0; n < 2; ++n) bv[bj][n] = *(const f32x4*)(bd + u.e * DM + col0 + bj * HALF + 4 * n);
#pragma unroll
        for (int ai = 0; ai < 2; ++ai)
#pragma unroll
            for (int m = 0; m < 4; ++m) { const int r = ai * HALF + wr * 64 + m * 16 + fr;
                if (r < u.nval) { const float gw = glist[u.e * TOK2 + u.mt * 256 + r];
#pragma unroll
                    for (int bj = 0; bj < 2; ++bj) { const f32x4 v0 = (acc[ai][bj][m][0] + bv[bj][0]) * gw, v1 = (acc[ai][bj][m][1] + bv[bj][1]) * gw;
                        u32x4 w; w.x = pk2(v0[0], v0[1]); w.y = pk2(v0[2], v0[3]); w.z = pk2(v1[0], v1[1]); w.w = pk2(v1[2], v1[3]);
                        *(u32x4*)(Y + (size_t)(u.slot0 + r) * DM + col0 + bj * HALF) = w; } } }
    }
};
}

struct Args { const float* in[19]; float* out; unsigned char* ws; int ph_lo, ph_hi; };
struct Frame {
    LAS unsigned char* lds; gu32* ctl; int tid, lane, wave, G, vcu;
};
#define MFMA32(a, b, c) __builtin_amdgcn_mfma_f32_32x32x16_bf16((a), (b), (c), 0, 0, 0)
__device__ __forceinline__ int crow(int reg, int h) { return (reg & 3) + 8 * (reg >> 2) + 4 * h; }

__device__ __forceinline__ void p0_transpose_item(const float* W, int K, int N, bf16_t* WT, int dst_row0, int k0, int n0, LAS float* scr, int lane) {
    const int nn = n0 + (lane & 31); const bool ok = nn < N;
#pragma unroll 8
    for (int i = 0; i < 32; ++i) { const int kk = 2 * i + (lane >> 5); scr[kk * 33 + (lane & 31)] = ok ? W[(size_t)(k0 + kk) * N + nn] : 0.f; }
    LDS_WAIT(); asm volatile("" ::: "memory");
    const int c = lane & 7;
#pragma unroll
    for (int j = 0; j < 4; ++j) { const int n = (lane >> 3) + 8 * j; const LAS float* s = scr + (8 * c) * 33 + n;
        u32x4 o; o.x = pk2(s[0 * 33], s[1 * 33]); o.y = pk2(s[2 * 33], s[3 * 33]); o.z = pk2(s[4 * 33], s[5 * 33]); o.w = pk2(s[6 * 33], s[7 * 33]);
        if (n0 + n < N) *(u32x4*)(WT + (size_t)(dst_row0 + n) * K + k0 + 8 * c) = o; }
    LDS_WAIT(); asm volatile("" ::: "memory");
}
__device__ __forceinline__ void p0_prologue(const Frame& F, const Args& a) {
    unsigned char* ws = a.ws;
    LAS float* scr = (LAS float*)(F.lds + F.wave * 16384);
    const int gw = F.vcu * NWAVES + F.wave, NGW = F.G * NWAVES, lane = F.lane;
    {
        const float* x = a.in[0]; const float* meta = a.in[1]; const float* g = a.in[2]; bf16_t* XN = (bf16_t*)(ws + WS_XN);
        f32x4 gv[8];
#pragma unroll
        for (int j = 0; j < 8; ++j) gv[j] = ((const f32x4*)g)[lane + 64 * j];
        for (int r = gw; r < MPAD; r += NGW) {
            unsigned long long* o8 = (unsigned long long*)(XN + (size_t)r * DM) + lane;
            if (r >= TROWS) {
#pragma unroll
                for (int j = 0; j < 8; ++j) o8[64 * j] = 0ull;
                continue; }
            const int b = r / LL, l = r - b * LL;
            const f32x4* src = (const f32x4*)(l < NMETA ? meta + (size_t)l * DM : x + (size_t)(b * SEQ + l - NMETA) * DM) + lane;
            f32x4 v[8]; float s = 0.f;
#pragma unroll
            for (int j = 0; j < 8; ++j) { v[j] = src[64 * j]; s += (v[j].x * v[j].x + v[j].y * v[j].y) + (v[j].z * v[j].z + v[j].w * v[j].w); }
            const float rstd = 1.0f / sqrtf(wave_sum(s) * (1.0f / DM) + EPS);
#pragma unroll
            for (int j = 0; j < 8; ++j) { const f32x4 y = v[j] * rstd * gv[j]; o8[64 * j] = (unsigned long long)pk2(y.x, y.y) | ((unsigned long long)pk2(y.z, y.w) << 32); }
        }
    }
    {
        float* rope = (float*)(ws + WS_ROPE);
        for (int it = gw * 64 + lane; it < LL * 8; it += NGW * 64) { const int pos = it >> 3, j = it & 7;
            const float fr = (float)pow(500000.0, -(double)j / 8.0); const float ang = (float)pos * fr;
            rope[pos * 16 + j] = (float)cos((double)ang); rope[pos * 16 + 8 + j] = (float)sin((double)ang); }
    }
    {
        const float* pw = a.in[4]; const float* ps = a.in[5]; const float* wbp = a.in[6]; bf16_t* WE = (bf16_t*)(ws + WS_WEFF);
        for (int it = gw; it < 4 * 64 * 32; it += NGW) { const int g = it >> 11, c4 = (it >> 5) & 63, nb = it & 31, n = nb * 64 + lane;
            float acc0 = 0.f, acc1 = 0.f, acc2 = 0.f, acc3 = 0.f; const float* pr = pw + (size_t)(g * 256 + c4 * 4) * 256;
            for (int d = 0; d < 256; ++d) { const float wv = wbp[(size_t)(g * 256 + d) * DM + n] * ps[g * 256 + d];
                acc0 += pr[d] * wv; acc1 += pr[256 + d] * wv; acc2 += pr[512 + d] * wv; acc3 += pr[768 + d] * wv; }
            *(u32x2*)(WE + (size_t)n * 1024 + g * 256 + c4 * 4) = (u32x2){pk2(acc0, acc1), pk2(acc2, acc3)}; }
    }
    {
        constexpr int I_IN = 32 * 291, I_BA = 16 * 64, I_OUT = 32 * 64, I_EXP = 32 * 64;
        constexpr int NITEMS = I_IN + I_BA + I_OUT + NE * 3 * I_EXP;
        for (int it = gw; it < NITEMS; it += NGW) {
            int r = it;
            if (r < I_IN) { const int kb = r / 291, nb = r % 291; p0_transpose_item(a.in[3], DM, DIN, (bf16_t*)(ws + WS_WIN), nb * 32, kb * 64, nb * 32, scr, lane); continue; } r -= I_IN;
            if (r < I_BA) { const int kb = r / 64, nb = r % 64; p0_transpose_item(a.in[7], 1024, DM, (bf16_t*)(ws + WS_WBA), nb * 32, kb * 64, nb * 32, scr, lane); continue; } r -= I_BA;
            if (r < I_OUT) { const int kb = r / 64, nb = r % 64; p0_transpose_item(a.in[8], DM, DM, (bf16_t*)(ws + WS_WOUT), nb * 32, kb * 64, nb * 32, scr, lane); continue; } r -= I_OUT;
            const int e = r / (3 * I_EXP), rr = r % (3 * I_EXP), mat = rr / I_EXP, q = rr % I_EXP, kb = q / 64, nb = q % 64, n0 = nb * 32;
            if (mat == 0) p0_transpose_item(a.in[12] + (size_t)e * DM * DFF, DM, DFF, (bf16_t*)(ws + WS_WGU) + (size_t)e * 4096 * DM, (n0 >> 7) * 256 + (n0 & 127), kb * 64, n0, scr, lane);
            else if (mat == 1) p0_transpose_item(a.in[14] + (size_t)e * DM * DFF, DM, DFF, (bf16_t*)(ws + WS_WGU) + (size_t)e * 4096 * DM, (n0 >> 7) * 256 + 128 + (n0 & 127), kb * 64, n0, scr, lane);
            else p0_transpose_item(a.in[16] + (size_t)e * DFF * DM, DFF, DM, (bf16_t*)(ws + WS_WD) + (size_t)e * DM * DFF, n0, kb * 64, n0, scr, lane);
        }
    }
}

__device__ __forceinline__ void p2_elementwise(const Frame& F, const Args& a) {
    unsigned char* ws = a.ws; bf16_t* P = (bf16_t*)(ws + WS_P); bf16_t* POOL = (bf16_t*)(ws + WS_POOL); bf16_t* VT = (bf16_t*)(ws + WS_VT); const float* rope = (const float*)(ws + WS_ROPE);
    const int tid = F.tid, lane = F.lane, wave = F.wave;
    for (int unit = F.vcu; unit < NB * 65; unit += F.G) {
        const int b = unit / 65, st = unit % 65, l0 = st * 64, nl = (LL - l0) < 64 ? (LL - l0) : 64;
        const size_t rowb = (size_t)b * LL;
        {
            const int w = 2 << (tid >> 7); float s0 = 0.f, s1 = 0.f;
            for (int i = (l0 - w > 0 ? l0 - w : 0); i < l0; ++i) { const unsigned v = *(const unsigned*)(P + (rowb + i) * DINP + C_U + 2 * tid); s0 += bflo(v); s1 += bfhi(v); }
            for (int l = l0; l < l0 + nl; ++l) {
                const unsigned v = *(const unsigned*)(P + (rowb + l) * DINP + C_U + 2 * tid); const float u0 = bflo(v), u1 = bfhi(v);
                s0 += u0; s1 += u1;
                if (l - w >= 0) { const unsigned o = *(const unsigned*)(P + (rowb + l - w) * DINP + C_U + 2 * tid); s0 -= bflo(o); s1 -= bfhi(o); }
                const float ic = 1.0f / (float)((l + 1) < w ? (l + 1) : w);
                *(unsigned*)(POOL + (rowb + l) * 1024 + 2 * tid) = pk2(s0 * ic - u0, s1 * ic - u1);
            }
        }
        for (int it = tid; it < nl * 49; it += NTHR) {
            const int rl = it / 49, hs = it % 49, l = l0 + rl;
            const int col = hs < 16 ? C_Q + hs * 64 : (hs < 32 ? C_K + (hs - 16) * 64 : (hs < 48 ? C_IQ + (hs - 32) * 64 : C_IK));
            bf16_t* p = P + (rowb + l) * DINP + col;
            const u32x4 x1 = *(const u32x4*)p, x2 = *(const u32x4*)(p + 8);
            const f32x4 c0 = *(const f32x4*)(rope + l * 16), c1 = *(const f32x4*)(rope + l * 16 + 4), s0 = *(const f32x4*)(rope + l * 16 + 8), s1 = *(const f32x4*)(rope + l * 16 + 12);
            const float a0 = bflo(x1.x), a1 = bfhi(x1.x), a2 = bflo(x1.y), a3 = bfhi(x1.y), a4 = bflo(x1.z), a5 = bfhi(x1.z), a6 = bflo(x1.w), a7 = bfhi(x1.w);
            const float b0 = bflo(x2.x), b1 = bfhi(x2.x), b2 = bflo(x2.y), b3 = bfhi(x2.y), b4 = bflo(x2.z), b5 = bfhi(x2.z), b6 = bflo(x2.w), b7 = bfhi(x2.w);
            u32x4 o1, o2;
            o1.x = pk2(a0 * c0.x - b0 * s0.x, a1 * c0.y - b1 * s0.y); o1.y = pk2(a2 * c0.z - b2 * s0.z, a3 * c0.w - b3 * s0.w);
            o1.z = pk2(a4 * c1.x - b4 * s1.x, a5 * c1.y - b5 * s1.y); o1.w = pk2(a6 * c1.z - b6 * s1.z, a7 * c1.w - b7 * s1.w);
            o2.x = pk2(b0 * c0.x + a0 * s0.x, b1 * c0.y + a1 * s0.y); o2.y = pk2(b2 * c0.z + a2 * s0.z, b3 * c0.w + a3 * s0.w);
            o2.z = pk2(b4 * c1.x + a4 * s1.x, b5 * c1.y + a5 * s1.y); o2.w = pk2(b6 * c1.z + a6 * s1.z, b7 * c1.w + a7 * s1.w);
            *(u32x4*)p = o1; *(u32x4*)(p + 8) = o2;
        }
        for (int hh = 0; hh < 2; ++hh) {
            const int hd = 2 * wave + hh; const int l = l0 + lane;
            u32x4 v[8];
            if (l < LL) {
#pragma unroll
                for (int j = 0; j < 8; ++j) v[j] = *(const u32x4*)(P + (rowb + l) * DINP + C_V + hd * 64 + 8 * j);
            } else {
#pragma unroll
                for (int j = 0; j < 8; ++j) v[j] = (u32x4){0u, 0u, 0u, 0u};
            }
            bf16_t* dst = VT + (size_t)((b * NH + hd) * 64) * KPAD + l;
#pragma unroll
            for (int j = 0; j < 8; ++j) {
                dst[(size_t)(8 * j + 0) * KPAD] = (bf16_t)(v[j].x & 0xffffu); dst[(size_t)(8 * j + 1) * KPAD] = (bf16_t)(v[j].x >> 16);
                dst[(size_t)(8 * j + 2) * KPAD] = (bf16_t)(v[j].y & 0xffffu); dst[(size_t)(8 * j + 3) * KPAD] = (bf16_t)(v[j].y >> 16);
                dst[(size_t)(8 * j + 4) * KPAD] = (bf16_t)(v[j].z & 0xffffu); dst[(size_t)(8 * j + 5) * KPAD] = (bf16_t)(v[j].z >> 16);
                dst[(size_t)(8 * j + 6) * KPAD] = (bf16_t)(v[j].w & 0xffffu); dst[(size_t)(8 * j + 7) * KPAD] = (bf16_t)(v[j].w >> 16);
            }
        }
    }
}

constexpr int SC_PITCH = 4160;
__device__ __forceinline__ unsigned f2key(float f) { const unsigned u = __float_as_uint(f); return u ^ ((unsigned)((int)u >> 31) | 0x80000000u); }
__device__ __forceinline__ void p3_select(const Frame& F, const Args& a) {
    unsigned char* ws = a.ws; const bf16_t* P = (const bf16_t*)(ws + WS_P); unsigned long long* MASK = (unsigned long long*)(ws + WS_MASK);
    LAS float* sc = (LAS float*)F.lds; volatile LAS int* tick = (volatile LAS int*)(F.lds + LDSCTL_OFF + 64);
    const int lane = F.lane, wave = F.wave, r32 = lane & 31, hh = lane >> 5;
    for (;;) {
        __syncthreads();
        if (F.tid == 0) tick[0] = (int)__hip_atomic_fetch_add(F.ctl + CW_TICKET, 1u, RLX_AGENT);
        __syncthreads();
        const int ui = tick[0];
        if (ui >= NB * 514) break;
        const int grp = 513 - ui / NB, b = ui % NB, l0 = grp * 8;
        const size_t rowb = (size_t)b * LL;
        const int q = l0 + wave;
        if (l0 >= NSEL) {
            const int pr = wave & 3, par = wave >> 2, qa = l0 + 2 * pr;
            const int ntl = (l0 + 8 + 31) >> 5;
            bf16x8 af[4]; float sg[16];
            {
                const int qq = qa + ((r32 >> 2) & 1), head = (r32 >> 3) * 4 + (r32 & 3);
                const bf16_t* qrow = P + (rowb + qq) * DINP;
                const float wsc = fabsf(bf2f(qrow[C_IW + head])) * 0.03125f;
#pragma unroll
                for (int c = 0; c < 4; ++c) { const u32x4 v = *(const u32x4*)(qrow + C_IQ + head * 64 + 16 * c + 8 * hh); u32x4 o;
                    o.x = pk2(bflo(v.x) * wsc, bfhi(v.x) * wsc); o.y = pk2(bflo(v.y) * wsc, bfhi(v.y) * wsc); o.z = pk2(bflo(v.z) * wsc, bfhi(v.z) * wsc); o.w = pk2(bflo(v.w) * wsc, bfhi(v.w) * wsc);
                    af[c] = __builtin_bit_cast(bf16x8, o); }
                const bf16_t* wrow = P + (rowb + qa + hh) * DINP + C_IW;
                const u32x4 w0 = *(const u32x4*)wrow, w1 = *(const u32x4*)(wrow + 8);
                const unsigned ww[8] = {w0.x, w0.y, w0.z, w0.w, w1.x, w1.y, w1.z, w1.w};
#pragma unroll
                for (int i = 0; i < 8; ++i) { sg[2 * i] = bflo(ww[i]) < 0.f ? -1.f : 1.f; sg[2 * i + 1] = bfhi(ww[i]) < 0.f ? -1.f : 1.f; }
            }
            for (int t = par; t < ntl; t += 2) {
                const bf16_t* krow = P + (rowb + 32 * t + r32) * DINP + C_IK + 8 * hh;
                f32x16 z = {};
#pragma unroll
                for (int c = 0; c < 4; ++c) { const bf16x8 bfrag = *(const bf16x8*)(krow + 16 * c); z = MFMA32(af[c], bfrag, z); }
                float s = 0.f;
#pragma unroll
                for (int i = 0; i < 16; ++i) s += sg[i] * fmaxf(z[i], 0.f);
                sc[(2 * pr + hh) * SC_PITCH + 32 * t + r32] = s;
            }
        }
        __syncthreads();
        unsigned long long* mrow = MASK + (rowb + q) * MASKW;
        if (l0 < NSEL) {
            for (int i = lane; i < MASKW; i += 64) { const int lo = 64 * i; unsigned long long wv = 0ull;
                if (lo + 63 <= q) wv = ~0ull; else if (lo <= q) wv = (~0ull) >> (63 - (q - lo));
                mrow[i] = wv; }
        } else {
            const int n = q + 1;
            unsigned key[65];
#pragma unroll
            for (int i = 0; i < 65; ++i) { const int k = 64 * i + lane; key[i] = k < n ? f2key(sc[wave * SC_PITCH + k]) : 0u; }
            unsigned Pfx = 0u; bool exact = false;
            for (int bit = 31; bit >= 0; --bit) {
                const unsigned cand = Pfx | (1u << bit); int c = 0;
#pragma unroll
                for (int i = 0; i < 65; ++i) c += (key[i] >= cand) ? 1 : 0;
                c = wave_sum_i(c);
                if (c >= NSEL) { Pfx = cand; if (c == NSEL) { exact = true; break; } }
            }
            unsigned long long myw = 0ull, myw2 = 0ull;
            if (exact) {
#pragma unroll
                for (int i = 0; i < 65; ++i) { const unsigned long long bl = __ballot(key[i] >= Pfx); if (i < 64) { if (lane == i) myw = bl; } else { if (lane == 0) myw2 = bl; } }
            } else {
                int g = 0;
#pragma unroll
                for (int i = 0; i < 65; ++i) g += (key[i] > Pfx) ? 1 : 0;
                g = wave_sum_i(g);
                int need = NSEL - g, run = 0;
#pragma unroll
                for (int i = 0; i < 65; ++i) { const bool eq = key[i] == Pfx; const unsigned long long be = __ballot(eq);
                    const int rank = run + __builtin_amdgcn_mbcnt_hi((unsigned)(be >> 32), __builtin_amdgcn_mbcnt_lo((unsigned)be, 0u));
                    const bool sel = (key[i] > Pfx) || (eq && rank < need);
                    const unsigned long long bl = __ballot(sel); run += __builtin_popcountll(be);
                    if (i < 64) { if (lane == i) myw = bl; } else { if (lane == 0) myw2 = bl; } }
            }
            mrow[lane] = myw;
            if (lane == 0) mrow[64] = myw2;
            if (lane == 1) mrow[65] = 0ull;
        }
    }
}

constexpr int KV_PITCH = 72;
constexpr int KV_TILE = 64 * KV_PITCH * 2;
__device__ __forceinline__ void p4_attention(const Frame& F, const Args& a) {
    unsigned char* ws = a.ws; const bf16_t* P = (const bf16_t*)(ws + WS_P); const bf16_t* VT = (const bf16_t*)(ws + WS_VT); bf16_t* O = (bf16_t*)(ws + WS_O);
    const unsigned long long* MASK = (const unsigned long long*)(ws + WS_MASK);
    LAS unsigned char* lds = F.lds; volatile LAS int* tick = (volatile LAS int*)(F.lds + LDSCTL_OFF + 64);
    const int tid = F.tid, lane = F.lane, wave = F.wave, r32 = lane & 31, hh = lane >> 5;
    const int srow = tid >> 3, sch = tid & 7;
    const float CS = 0.125f * LOG2E;
    for (;;) {
        __syncthreads();
        if (tid == 0) tick[0] = (int)__hip_atomic_fetch_add(F.ctl + CW_TICKET + 64, 1u, RLX_AGENT);
        __syncthreads();
        const int ui = tick[0];
        if (ui >= NB * NH * 17) break;
        const int jb = 16 - ui / (NB * NH), bh = ui % (NB * NH), b = bh / NH, hd = bh % NH;
        const int q_lo = jb == 0 ? 0 : 16 + 256 * (jb - 1), nrows = jb == 0 ? 16 : 256, q_hi = q_lo + nrows - 1, nt = q_hi / 64 + 1;
        const size_t rowb = (size_t)b * LL;
        const int qrel = 32 * wave + r32; int q = q_lo + qrel; const bool qvalid = qrel < nrows; if (q > LL - 1) q = LL - 1;
        const int qmax_w = q_lo + 32 * wave + 31;
        bf16x8 qf[4];
#pragma unroll
        for (int c = 0; c < 4; ++c) qf[c] = *(const bf16x8*)(P + (rowb + q) * DINP + C_Q + hd * 64 + 16 * c + 8 * hh);
        const unsigned long long* mq = MASK + (rowb + q) * MASKW;
        const bf16_t* kbase = P + rowb * DINP + C_K + hd * 64 + sch * 8;
        const bf16_t* vbase = VT + (size_t)((b * NH + hd) * 64 + srow) * KPAD + sch * 8;
        f32x16 o0 = {}, o1 = {}; float m = -1e30f, lsum = 0.f;
        u32x4 kreg = *(const u32x4*)(kbase + (size_t)srow * DINP), vreg = *(const u32x4*)(vbase);
        *(LAS u32x4*)(lds + srow * (KV_PITCH * 2) + sch * 16) = kreg; *(LAS u32x4*)(lds + KV_TILE + srow * (KV_PITCH * 2) + sch * 16) = vreg;
        __syncthreads();
        for (int kt = 0; kt < nt; ++kt) {
            const int buf = kt & 1; LAS unsigned char* Kl = lds + buf * 2 * KV_TILE; LAS unsigned char* Vl = Kl + KV_TILE;
            if (kt + 1 < nt) { kreg = *(const u32x4*)(kbase + (size_t)(64 * (kt + 1) + srow) * DINP); vreg = *(const u32x4*)(vbase + 64 * (kt + 1)); }
            if (64 * kt <= qmax_w) {
                f32x16 p0 = {}, p1 = {};
#pragma unroll
                for (int c = 0; c < 4; ++c) {
                    const bf16x8 k0 = *(const LAS bf16x8*)(Kl + r32 * (KV_PITCH * 2) + (16 * c + 8 * hh) * 2);
                    const bf16x8 k1 = *(const LAS bf16x8*)(Kl + (32 + r32) * (KV_PITCH * 2) + (16 * c + 8 * hh) * 2);
                    p0 = MFMA32(k0, qf[c], p0); p1 = MFMA32(k1, qf[c], p1); }
                const unsigned long long mw = mq[kt]; const unsigned wlo = (unsigned)mw >> (4 * hh), whi = (unsigned)(mw >> 32) >> (4 * hh);
                float mx = -INFINITY;
#pragma unroll
                for (int i = 0; i < 16; ++i) { const int bp = (i & 3) + 8 * (i >> 2);
                    p0[i] = ((wlo >> bp) & 1u) ? p0[i] * CS : -INFINITY; p1[i] = ((whi >> bp) & 1u) ? p1[i] * CS : -INFINITY;
                    mx = fmaxf(mx, fmaxf(p0[i], p1[i])); }
                mx = fmaxf(mx, __shfl_xor(mx, 32));
                const float mn = fmaxf(m, mx), alpha = __builtin_amdgcn_exp2f(m - mn); m = mn;
                float ps = 0.f;
#pragma unroll
                for (int i = 0; i < 16; ++i) { p0[i] = __builtin_amdgcn_exp2f(p0[i] - mn); p1[i] = __builtin_amdgcn_exp2f(p1[i] - mn); ps += p0[i] + p1[i]; }
                lsum = lsum * alpha + ps;
#pragma unroll
                for (int i = 0; i < 16; ++i) { o0[i] *= alpha; o1[i] *= alpha; }
#pragma unroll
                for (int blk = 0; blk < 2; ++blk)
#pragma unroll
                    for (int s = 0; s < 2; ++s) {
                        u32x4 pw;
                        if (blk == 0) { pw.x = pk2(p0[8 * s], p0[8 * s + 1]); pw.y = pk2(p0[8 * s + 2], p0[8 * s + 3]); pw.z = pk2(p0[8 * s + 4], p0[8 * s + 5]); pw.w = pk2(p0[8 * s + 6], p0[8 * s + 7]); }
                        else { pw.x = pk2(p1[8 * s], p1[8 * s + 1]); pw.y = pk2(p1[8 * s + 2], p1[8 * s + 3]); pw.z = pk2(p1[8 * s + 4], p1[8 * s + 5]); pw.w = pk2(p1[8 * s + 6], p1[8 * s + 7]); }
                        const bf16x8 pf = __builtin_bit_cast(bf16x8, pw);
                        const int kofs = (blk * 32 + 16 * s + 4 * hh) * 2;
                        {   const s16x4 va = *(const LAS s16x4*)(Vl + r32 * (KV_PITCH * 2) + kofs), vb = *(const LAS s16x4*)(Vl + r32 * (KV_PITCH * 2) + kofs + 16);
                            const bf16x8 vf = __builtin_shufflevector(va, vb, 0, 1, 2, 3, 4, 5, 6, 7); o0 = MFMA32(vf, pf, o0); }
                        {   const s16x4 va = *(const LAS s16x4*)(Vl + (32 + r32) * (KV_PITCH * 2) + kofs), vb = *(const LAS s16x4*)(Vl + (32 + r32) * (KV_PITCH * 2) + kofs + 16);
                            const bf16x8 vf = __builtin_shufflevector(va, vb, 0, 1, 2, 3, 4, 5, 6, 7); o1 = MFMA32(vf, pf, o1); }
                    }
            }
            if (kt + 1 < nt) { LAS unsigned char* Kn = lds + (buf ^ 1) * 2 * KV_TILE;
                *(LAS u32x4*)(Kn + srow * (KV_PITCH * 2) + sch * 16) = kreg; *(LAS u32x4*)(Kn + KV_TILE + srow * (KV_PITCH * 2) + sch * 16) = vreg; }
            __syncthreads();
        }
        const float lt = lsum + __shfl_xor(lsum, 32); const float inv = 1.0f / lt;
        if (qvalid) {
            bf16_t* orow = O + (rowb + q) * 1024 + hd * 64;
#pragma unroll
            for (int g = 0; g < 4; ++g) {
                *(u32x2*)(orow + 8 * g + 4 * hh) = (u32x2){pk2(o0[4 * g] * inv, o0[4 * g + 1] * inv), pk2(o0[4 * g + 2] * inv, o0[4 * g + 3] * inv)};
                *(u32x2*)(orow + 32 + 8 * g + 4 * hh) = (u32x2){pk2(o1[4 * g] * inv, o1[4 * g + 1] * inv), pk2(o1[4 * g + 2] * inv, o1[4 * g + 3] * inv)}; }
        }
    }
}

__device__ __forceinline__ void p7_router(const Frame& F, const Args& a) {
    unsigned char* ws = a.ws; const float* H1 = a.out; bf16_t* XN2 = (bf16_t*)(ws + WS_XN);
    const float* g2 = a.in[9]; const float* rw = a.in[10]; const float* rb = a.in[11];
    int* tok_e = (int*)(ws + WS_ROUTE + RT_TOKE); int* tok_p = (int*)(ws + WS_ROUTE + RT_TOKP); int* list = (int*)(ws + WS_ROUTE + RT_LIST); float* glist = (float*)(ws + WS_ROUTE + RT_GLIST);
    LAS float* xs = (LAS float*)F.lds;
    LAS float* wsm = xs + 128 * 68;
    LAS float* lg = wsm + 64 * 32;
    LAS float* rs = lg + 128 * 33;
    LAS int* hist = (LAS int*)(rs + 128);
    LAS int* gbase = hist + 32;
    const int tid = F.tid, lane = F.lane, wave = F.wave;
    for (int tile = F.vcu; tile < TOK2 / 128; tile += F.G) {
        const int t0 = tile * 128;
        const int tt = tid & 63, eg = tid >> 6;
        float acc[2][4] = {{0.f, 0.f, 0.f, 0.f}, {0.f, 0.f, 0.f, 0.f}}; float ssq0 = 0.f, ssq1 = 0.f;
        if (tid < 32) hist[tid] = 0;
        for (int kc = 0; kc < DM / 64; ++kc) {
            __syncthreads();
#pragma unroll
            for (int j = 0; j < 4; ++j) { const int idx = tid + 512 * j, row = idx >> 4, c4 = idx & 15;
                *(LAS f32x4*)(xs + row * 68 + c4 * 4) = *(const f32x4*)(H1 + (size_t)(t0 + row) * DM + kc * 64 + c4 * 4); }
            { const int d = tid >> 3, e4 = tid & 7; const f32x4 wv = *(const f32x4*)(rw + (size_t)(kc * 64 + d) * NE + e4 * 4); *(LAS f32x4*)(wsm + d * 32 + e4 * 4) = wv * g2[kc * 64 + d]; }
            __syncthreads();
#pragma unroll 4
            for (int k4 = 0; k4 < 16; ++k4) {
                const f32x4 xa = *(const LAS f32x4*)(xs + tt * 68 + 4 * k4), xb = *(const LAS f32x4*)(xs + (tt + 64) * 68 + 4 * k4);
#pragma unroll
                for (int kk = 0; kk < 4; ++kk) { const f32x4 wv = *(const LAS f32x4*)(wsm + (4 * k4 + kk) * 32 + 4 * eg);
#pragma unroll
                    for (int j = 0; j < 4; ++j) { acc[0][j] += xa[kk] * wv[j]; acc[1][j] += xb[kk] * wv[j]; }
                    ssq0 += xa[kk] * xa[kk]; ssq1 += xb[kk] * xb[kk]; }
            }
        }
        const float r0 = 1.0f / sqrtf(ssq0 * (1.0f / DM) + EPS), r1 = 1.0f / sqrtf(ssq1 * (1.0f / DM) + EPS);
#pragma unroll
        for (int j = 0; j < 4; ++j) { lg[tt * 33 + 4 * eg + j] = acc[0][j] * r0 + rb[4 * eg + j]; lg[(tt + 64) * 33 + 4 * eg + j] = acc[1][j] * r1 + rb[4 * eg + j]; }
        if (eg == 0) { rs[tt] = r0; rs[tt + 64] = r1; }
        __syncthreads();
        int te[4], tl[4]; float tg[4];
        if (tid < 128) {
            float v[32];
#pragma unroll
            for (int e = 0; e < 32; ++e) v[e] = lg[tid * 33 + e];
            float tv[4];
#pragma unroll
            for (int k = 0; k < 4; ++k) { float best = -INFINITY; int bi = 0;
#pragma unroll
                for (int e = 0; e < 32; ++e) { const bool tk = v[e] > best; best = tk ? v[e] : best; bi = tk ? e : bi; }
                tv[k] = best; te[k] = bi;
#pragma unroll
                for (int e = 0; e < 32; ++e) v[e] = (e == bi) ? -INFINITY : v[e]; }
            const float e1 = __expf(tv[1] - tv[0]), e2 = __expf(tv[2] - tv[0]), e3 = __expf(tv[3] - tv[0]); const float inv = 1.0f / (1.0f + e1 + e2 + e3);
            tg[0] = inv; tg[1] = e1 * inv; tg[2] = e2 * inv; tg[3] = e3 * inv;
#pragma unroll
            for (int k = 0; k < 4; ++k) tl[k] = atomicAdd((int*)&hist[te[k]], 1);
        }
        __syncthreads();
        if (tid < 32) gbase[tid] = (int)__hip_atomic_fetch_add(F.ctl + CW_CURSOR + tid, (unsigned)hist[tid], RLX_AGENT);
        __syncthreads();
        if (tid < 128) {
            const int t2 = t0 + tid;
#pragma unroll
            for (int k = 0; k < 4; ++k) { const int pos = gbase[te[k]] + tl[k]; list[te[k] * TOK2 + pos] = t2; glist[te[k] * TOK2 + pos] = tg[k]; tok_e[t2 * 4 + k] = te[k]; tok_p[t2 * 4 + k] = pos; }
        }
        f32x4 gv[8];
#pragma unroll
        for (int j = 0; j < 8; ++j) gv[j] = ((const f32x4*)g2)[lane + 64 * j];
        for (int rr = 0; rr < 16; ++rr) { const int row = wave * 16 + rr; const float rstd = rs[row];
            const f32x4* src = (const f32x4*)(H1 + (size_t)(t0 + row) * DM) + lane; unsigned long long* o8 = (unsigned long long*)(XN2 + (size_t)(t0 + row) * DM) + lane;
#pragma unroll
            for (int j = 0; j < 8; ++j) { const f32x4 y = src[64 * j] * rstd * gv[j]; o8[64 * j] = (unsigned long long)pk2(y.x, y.y) | ((unsigned long long)pk2(y.z, y.w) << 32); } }
        __syncthreads();
    }
}

__device__ __forceinline__ void moe_tables(const Frame& F, LAS int* tp, LAS int* cb) {
    __syncthreads();
    if (F.tid == 0) { int t = 0, c = 0;
        for (int e = 0; e < NE; ++e) { tp[e] = t; cb[e] = c; const int n = (int)__hip_atomic_load(F.ctl + CW_CURSOR + e, RLX_AGENT); t += (n + 255) >> 8; c += n; }
        tp[NE] = t; cb[NE] = c; }
    __syncthreads();
}

__device__ __forceinline__ void p11_combine(const Frame& F, const Args& a, const LAS int* cb) {
    unsigned char* ws = a.ws; float* out = a.out; const bf16_t* Y = (const bf16_t*)(ws + WS_Y); const float* gf = a.in[18];
    const int* tok_e = (const int*)(ws + WS_ROUTE + RT_TOKE); const int* tok_p = (const int*)(ws + WS_ROUTE + RT_TOKP);
    const int gw = F.vcu * NWAVES + F.wave, NGW = F.G * NWAVES, lane = F.lane;
    f32x4 gv[8];
#pragma unroll
    for (int j = 0; j < 8; ++j) gv[j] = ((const f32x4*)gf)[lane + 64 * j];
    for (int t2 = gw; t2 < TOK2; t2 += NGW) {
        f32x4* row = (f32x4*)(out + (size_t)t2 * DM) + lane;
        f32x4 v[8];
#pragma unroll
        for (int j = 0; j < 8; ++j) v[j] = row[64 * j];
#pragma unroll
        for (int k = 0; k < 4; ++k) { const int e = tok_e[t2 * 4 + k], slot = cb[e] + tok_p[t2 * 4 + k];
            const u32x2* yr = (const u32x2*)(Y + (size_t)slot * DM) + lane;
#pragma unroll
            for (int j = 0; j < 8; ++j) { const u32x2 w = yr[64 * j]; v[j].x += bflo(w.x); v[j].y += bfhi(w.x); v[j].z += bflo(w.y); v[j].w += bfhi(w.y); } }
        float s = 0.f;
#pragma unroll
        for (int j = 0; j < 8; ++j) s += (v[j].x * v[j].x + v[j].y * v[j].y) + (v[j].z * v[j].z + v[j].w * v[j].w);
        const float rstd = 1.0f / sqrtf(wave_sum(s) * (1.0f / DM) + EPS);
#pragma unroll
        for (int j = 0; j < 8; ++j) row[64 * j] = v[j] * rstd * gv[j];
    }
}

constexpr int NPHASE = 11;
__global__ void __launch_bounds__(NTHR, 2) fwd_kernel(Args args) {
    extern __shared__ __attribute__((aligned(16))) unsigned char lds_raw[];
    Frame F;
    F.lds = (LAS unsigned char*)lds_raw;
    F.tid = threadIdx.x; F.lane = F.tid & 63; F.wave = __builtin_amdgcn_readfirstlane(F.tid >> 6);
    F.G = gridDim.x; { const int bx = blockIdx.x; F.vcu = (F.G % 8 == 0) ? (bx % 8) * (F.G / 8) + bx / 8 : bx; }
    unsigned char* ws = args.ws;
    F.ctl = (gu32*)(ws + WS_CTL);
    for (int u = F.tid; u < (LDS_BYTES - LDSCTL_OFF) / 4; u += NTHR) ((LAS unsigned*)(F.lds + LDSCTL_OFF))[u] = 0u;
    __syncthreads();
    volatile LAS unsigned* MISC = (volatile LAS unsigned*)(F.lds + LDSCTL_OFF);
    LAS int* tp = (LAS int*)(F.lds + LDSCTL_OFF + 256); LAS int* cb = tp + 40;
    const int lo = args.ph_lo, hi = args.ph_hi;
    const bool one = (hi - lo) > 1;
    XcdBarrier bar; bar.bar = (unsigned*)(F.ctl + CW_BAR); bar.x = 0; bar.st = nullptr;
    if (one) bar = xcd_barrier_post((unsigned*)(F.ctl + CW_BAR), MISC + 8);
#ifndef PH_MASK
#define PH_MASK 0x7ff
#endif
#define IN(k) ((((PH_MASK) >> (k)) & 1) && lo <= (k) && (k) < hi)
#define SEAM(k) do { if (IN(k) && IN((k) + 1)) xcd_barrier(bar); } while (0)
    const int G = F.G, cid = (int)blockIdx.x;

    if (IN(0)) { p0_prologue(F, args); } SEAM(0);

    if (IN(1)) {
        pg8::DenseOrder S; S.init(MPAD / 256, DINP / 256, G, cid, ws + WS_WIN, DM); pg8::DenseA AM{DM}; pg8::EpiBf16 E{(bf16_t*)(ws + WS_P), DINP};
        pg8::gemm_phase<pg8::EpiBf16, pg8::DenseOrder, pg8::DenseA, true>(F.lds, (const char*)(ws + WS_XN), DM, S, AM, E);
    } SEAM(1);

    if (IN(2)) { p2_elementwise(F, args); } SEAM(2);

    if (IN(3)) {
        pg8::DenseOrder S; S.init(MPAD / 256, DM / 256, G, cid, ws + WS_WEFF, 1024); pg8::DenseA AM{1024}; pg8::EpiGate<false> E{(bf16_t*)(ws + WS_MG), (const bf16_t*)(ws + WS_P), C_GP};
        pg8::gemm_phase<pg8::EpiGate<false>, pg8::DenseOrder, pg8::DenseA, true>(F.lds, (const char*)(ws + WS_POOL), 1024, S, AM, E);
        p3_select(F, args);
    } SEAM(3);

    if (IN(4)) { p4_attention(F, args); } SEAM(4);

    if (IN(5)) {
        pg8::DenseOrder S; S.init(MPAD / 256, DM / 256, G, cid, ws + WS_WBA, 1024); pg8::DenseA AM{1024}; pg8::EpiGate<true> E{(bf16_t*)(ws + WS_MG), (const bf16_t*)(ws + WS_P), C_GA};
        pg8::gemm_phase<pg8::EpiGate<true>, pg8::DenseOrder, pg8::DenseA, true>(F.lds, (const char*)(ws + WS_O), 1024, S, AM, E);
    } SEAM(5);

    if (IN(6)) {
        pg8::DenseOrder S; S.init(MPAD / 256, DM / 256, G, cid, ws + WS_WOUT, DM); pg8::DenseA AM{DM}; pg8::EpiResid E{args.in[0], args.out};
        pg8::gemm_phase<pg8::EpiResid, pg8::DenseOrder, pg8::DenseA, true>(F.lds, (const char*)(ws + WS_MG), DM, S, AM, E);
    } SEAM(6);

    if (IN(7)) { p7_router(F, args); } SEAM(7);

    if (IN(8)) {
        moe_tables(F, tp, cb);
        pg8::MoeOrder S{tp, cb, 16, G, cid, (const char*)(ws + WS_WGU), (size_t)4096 * DM * 2, (size_t)256 * DM * 2};
        pg8::GatherA AM{(const int*)(ws + WS_ROUTE + RT_LIST), DM}; pg8::EpiSwiglu E{(bf16_t*)(ws + WS_HID), args.in[13], args.in[15]};
        pg8::gemm_phase<pg8::EpiSwiglu, pg8::MoeOrder, pg8::GatherA, true>(F.lds, (const char*)(ws + WS_XN), DM, S, AM, E);
    } SEAM(8);

    if (IN(9)) {
        moe_tables(F, tp, cb);
        pg8::MoeOrder S{tp, cb, 8, G, cid, (const char*)(ws + WS_WD), (size_t)DM * DFF * 2, (size_t)256 * DFF * 2};
        pg8::SlotA AM{DFF}; pg8::EpiDown E{(bf16_t*)(ws + WS_Y), args.in[17], (const float*)(ws + WS_ROUTE + RT_GLIST)};
        pg8::gemm_phase<pg8::EpiDown, pg8::MoeOrder, pg8::SlotA, true>(F.lds, (const char*)(ws + WS_HID), DFF, S, AM, E);
    } SEAM(9);

    if (IN(10)) { moe_tables(F, tp, cb); p11_combine(F, args, cb); }
#undef IN
#undef SEAM
}

extern "C" void kernel_launch(void* const* d_in, const int* in_sizes, int n_in, void* d_out, int out_size, void* d_ws, size_t ws_size, hipStream_t stream) {
    static int grid = 0;
    if (grid == 0) {
        if (n_in != 19 || out_size != TOK2 * DM || ws_size < WS_END) { fprintf(stderr, "kernel_launch: unexpected shapes (n_in %d out %d ws %zu)\n", n_in, out_size, ws_size); grid = -1; return; }
        int dev = 0, cus = 0, per_cu = 0;
        if (hipGetDevice(&dev) != hipSuccess || hipDeviceGetAttribute(&cus, hipDeviceAttributeMultiprocessorCount, dev) != hipSuccess) { grid = -1; return; }
        if (hipFuncSetAttribute((const void*)fwd_kernel, hipFuncAttributeMaxDynamicSharedMemorySize, LDS_BYTES) != hipSuccess) { fprintf(stderr, "kernel_launch: hipFuncSetAttribute failed\n"); grid = -1; return; }
        if (hipOccupancyMaxActiveBlocksPerMultiprocessor(&per_cu, (const void*)fwd_kernel, NTHR, LDS_BYTES) != hipSuccess || per_cu < 1) { fprintf(stderr, "kernel_launch: occupancy query says %d\n", per_cu); }
        (void)hipGetLastError();
        grid = cus;
    }
    if (grid < 0) return;
    if (hipMemsetAsync((char*)d_ws + WS_CTL, 0, CTL_ZERO_BYTES, stream) != hipSuccess) return;
    Args a{};
    for (int i = 0; i < 19; ++i) a.in[i] = (const float*)d_in[i];
    a.out = (float*)d_out; a.ws = (unsigned char*)d_ws;
#if MK_N_LAUNCHES == 1
    a.ph_lo = 0; a.ph_hi = NPHASE;
    hipLaunchKernelGGL(fwd_kernel, dim3(grid), dim3(NTHR), LDS_BYTES, stream, a);
#else
    for (int p = 0; p < NPHASE; ++p) { a.ph_lo = p; a.ph_hi = p + 1; hipLaunchKernelGGL(fwd_kernel, dim3(grid), dim3(NTHR), LDS_BYTES, stream, a); }
#endif
}
```

```cpp
#include <hip/hip_runtime.h>
#include <cstdio>
#include <cstdint>

#ifndef DBL
#define DBL -1
#endif
#ifndef MK_N_LAUNCHES
#define MK_N_LAUNCHES 1
#endif

#define GAS __attribute__((address_space(1)))
#define LAS __attribute__((address_space(3)))
typedef unsigned short bf16_t;
typedef short bf16x8 __attribute__((ext_vector_type(8)));
typedef short s16x4 __attribute__((ext_vector_type(4)));
typedef float f32x4 __attribute__((ext_vector_type(4)));
typedef float f32x16 __attribute__((ext_vector_type(16)));
typedef float f32x2 __attribute__((ext_vector_type(2)));
typedef __bf16 bf16x2_t __attribute__((ext_vector_type(2)));
typedef unsigned u32x4 __attribute__((ext_vector_type(4)));
typedef unsigned u32x2 __attribute__((ext_vector_type(2)));
typedef GAS unsigned gu32;
typedef int v4i_t __attribute__((ext_vector_type(4)));
typedef int v8i_t __attribute__((ext_vector_type(8)));

constexpr int DM = 2048, NB = 8, SEQ = 4096, NMETA = 16, LL = SEQ + NMETA;
constexpr int TROWS = NB * LL;
constexpr int MPAD = 33024;
constexpr int DIN = 9296, DINP = 9472;
constexpr int C_U = 0, C_Q = 1024, C_K = 2048, C_V = 3072, C_IQ = 4096, C_IK = 5120, C_IW = 5184, C_GP = 5200, C_GA = 7248;
constexpr int NH = 16, HD = 64, NE = 32, TOPK = 4, DFF = 2048;
constexpr int TOK2 = NB * SEQ;
constexpr int NASSIGN = TOK2 * TOPK;
constexpr int NSEL = 256;
constexpr int KPAD = 4160;
constexpr int MASKW = 66;
constexpr float EPS = 1e-5f;
constexpr float LOG2E = 1.4426950408889634f;

constexpr size_t MiB = 1u << 20;
constexpr size_t WS_CTL = 0, CTL_ZERO_BYTES = 1 * MiB;
constexpr size_t WS_ROPE = 1 * MiB;
constexpr size_t WS_ROUTE = 2 * MiB;
constexpr size_t RT_TOKE = 0, RT_TOKP = 1 * MiB, RT_LIST = 2 * MiB, RT_GLIST = 6 * MiB;
constexpr size_t WS_WIN = 12 * MiB;
constexpr size_t WS_WEFF = 49 * MiB;
constexpr size_t WS_WBA = 53 * MiB;
constexpr size_t WS_WOUT = 57 * MiB;
constexpr size_t WS_WGU = 65 * MiB;
constexpr size_t WS_WD = 321 * MiB;
constexpr size_t WS_XN = 449 * MiB;
constexpr size_t WS_P = 578 * MiB;
constexpr size_t WS_HID = WS_P;
constexpr size_t WS_POOL = 1175 * MiB;
constexpr size_t WS_O = 1240 * MiB;
constexpr size_t WS_MG = 1305 * MiB;
constexpr size_t WS_VT = 1434 * MiB;
constexpr size_t WS_MASK = 1499 * MiB;
constexpr size_t WS_Y = 1516 * MiB;
constexpr size_t WS_END = 2028 * MiB;
static_assert(WS_WIN + (size_t)DINP * DM * 2 <= WS_WEFF && WS_XN + (size_t)MPAD * DM * 2 <= WS_P && WS_P + (size_t)MPAD * DINP * 2 <= WS_POOL, "ws map");
static_assert(WS_HID + (size_t)(NASSIGN + 256) * DFF <= WS_POOL && WS_POOL + (size_t)MPAD * 1024 * 2 <= WS_O && WS_O + (size_t)MPAD * 1024 * 2 <= WS_MG, "ws map");
static_assert(WS_MG + (size_t)MPAD * DM * 2 <= WS_VT && WS_VT + (size_t)NB * NH * 64 * KPAD * 2 <= WS_MASK && WS_MASK + (size_t)TROWS * MASKW * 8 <= WS_Y, "ws map");
static_assert(WS_WGU + (size_t)NE * 4096 * 2048 <= WS_WD && WS_WD + (size_t)NE * 2048 * 2048 <= WS_XN && WS_Y + (size_t)NASSIGN * DM * 2 <= WS_END, "ws map");
constexpr float SC_W = 2048.0f, SC_X = 16.0f, SC_H = 4.0f;

constexpr int CW_TMO = 0;
constexpr int CW_TICKET = 64;
constexpr int CW_CURSOR = 1024;
constexpr int CW_BAR = 4096;

constexpr int RING_BYTES = 131072;
constexpr int IKST_OFF = 133120;
constexpr int LDSCTL_OFF = 151552;
constexpr int LDS_BYTES = 159744;
constexpr int NWAVES = 8, NTHR = 512;

#define RLX_AGENT __ATOMIC_RELAXED, __HIP_MEMORY_SCOPE_AGENT
#define LDS_WAIT() asm volatile("s_waitcnt lgkmcnt(0)" ::: "memory")
#define VM_WAIT() asm volatile("s_waitcnt vmcnt(0)" ::: "memory")

__device__ __forceinline__ unsigned f2bf(float f) { unsigned u = __builtin_bit_cast(unsigned, f); return (u + 0x7fffu + ((u >> 16) & 1u)) >> 16; }
__device__ __forceinline__ unsigned pk2(float lo, float hi) { f32x2 v = {lo, hi}; bf16x2_t b = __builtin_convertvector(v, bf16x2_t); return __builtin_bit_cast(unsigned, b); }
__device__ __forceinline__ float bf2f(unsigned short x) { return __uint_as_float(((unsigned)x) << 16); }
__device__ __forceinline__ float bflo(unsigned w) { return __uint_as_float(w << 16); }
__device__ __forceinline__ float bfhi(unsigned w) { return __uint_as_float(w & 0xffff0000u); }
__device__ __forceinline__ float sigmoidf_(float x) { return __builtin_amdgcn_rcpf(1.0f + __builtin_amdgcn_exp2f(-LOG2E * x)); }
__device__ __forceinline__ float wave_sum(float v) {
#pragma unroll
    for (int o = 1; o < 64; o <<= 1) v += __shfl_xor(v, o);
    return v;
}
__device__ __forceinline__ int wave_sum_i(int v) {
#pragma unroll
    for (int o = 1; o < 64; o <<= 1) v += __shfl_xor(v, o);
    return v;
}

#define XB_TMO      128
#define XB_XCNT(j)  (256  + 64 * (j))
#define XB_XSUB(j)  (1280 + 64 * (j))
#define XB_XGEN(j)  (2304 + 64 * (j))
#define XB_TOP      3328
#define XB_TOPGEN   3392
#define XCD_BAR_WORDS 3456
#define XB_SPIN_CAP (1u << 22)

__device__ __forceinline__ unsigned xb_ld(unsigned* p)              { return __hip_atomic_load(p, __ATOMIC_RELAXED, __HIP_MEMORY_SCOPE_AGENT); }
__device__ __forceinline__ unsigned xb_add(unsigned* p, unsigned v) { return __hip_atomic_fetch_add(p, v, __ATOMIC_RELAXED, __HIP_MEMORY_SCOPE_AGENT); }
__device__ __forceinline__ unsigned xb_xcc_id() { return (unsigned)__builtin_amdgcn_s_getreg((3 << 11) | 20) & 0xFu; }
#define XB_SPIN(cond, bar) do { unsigned _sp = 0; while (cond) { __builtin_amdgcn_s_sleep(1); \
    if ((++_sp & 255u) == 0u) { if (xb_ld(&(bar)[XB_TMO])) break; if (_sp > XB_SPIN_CAP) { atomicAdd(&(bar)[XB_TMO], 1u); break; } } } } while (0)

struct XcdBarrier { unsigned* bar; unsigned x; volatile LAS unsigned* st; };

__device__ __forceinline__ XcdBarrier xcd_barrier_post(unsigned* bar, volatile LAS unsigned* st) {
    XcdBarrier b; b.bar = bar; b.x = xb_xcc_id(); b.st = st;
    if (threadIdx.x == 0) (void)xb_add(&bar[XB_XCNT(b.x)], 1u);
    return b;
}
__device__ __forceinline__ void xcd_barrier_complete(unsigned* bar, unsigned x, unsigned& nloc, unsigned& nx) {
    const unsigned G = gridDim.x * gridDim.y * gridDim.z;
    unsigned sum, cnt, mine, sp = 0u;
    for (;;) {
        sum = 0u; cnt = 0u; mine = 0u;
#pragma unroll
        for (unsigned j = 0; j < 16; ++j) { const unsigned c = xb_ld(&bar[XB_XCNT(j)]); sum += c; cnt += (c > 0u) ? 1u : 0u; mine = (j == x) ? c : mine; }
        if (sum == G) break;
        __builtin_amdgcn_s_sleep(1);
        if ((++sp & 255u) == 0u) { if (xb_ld(&bar[XB_TMO])) break; if (sp > XB_SPIN_CAP) { atomicAdd(&bar[XB_TMO], 1u); break; } }
    }
    nloc = mine > 0u ? mine : 1u; nx = cnt > 0u ? cnt : 1u;
}
__device__ __forceinline__ void xcd_barrier(const XcdBarrier& b) {
    asm volatile("s_waitcnt vmcnt(0)" ::: "memory");
    __syncthreads();
    if (threadIdx.x == 0) {
        unsigned* bar = b.bar;
        __builtin_amdgcn_s_waitcnt(0);
        unsigned nloc = b.st[0], nx = b.st[1];
        if (nloc == 0u) { xcd_barrier_complete(bar, b.x, nloc, nx); b.st[0] = nloc; b.st[1] = nx; }
        const unsigned old = xb_add(&bar[XB_XSUB(b.x)], 1u);
        const unsigned gen = old / nloc;
        if (old + 1u == (gen + 1u) * nloc) {
            __builtin_amdgcn_fence(__ATOMIC_RELEASE, "agent");
            asm volatile("s_waitcnt vmcnt(0)" ::: "memory");
            const unsigned og = xb_add(&bar[XB_TOP], 1u);
            const unsigned tg = og / nx;
            if (og + 1u == (tg + 1u) * nx) xb_add(&bar[XB_TOPGEN], 1u);
            else XB_SPIN(xb_ld(&bar[XB_TOPGEN]) == tg, bar);
            __builtin_amdgcn_fence(__ATOMIC_ACQUIRE, "agent");
            xb_add(&bar[XB_XGEN(b.x)], 1u);
            asm volatile("s_waitcnt vmcnt(0)" ::: "memory");
        } else {
            XB_SPIN(xb_ld(&bar[XB_XGEN(b.x)]) == gen, bar);
            __builtin_amdgcn_fence(__ATOMIC_ACQUIRE, "agent");
            asm volatile("s_waitcnt vmcnt(0)" ::: "memory");
        }
    }
    __syncthreads();
}

namespace pg8 {
constexpr int BM = 256, BK = 64, HALF = 128, HTB = HALF * BK * 2, STAGE_BYTES = 8 * HTB;
__host__ __device__ __forceinline__ int lds_byte(int r, int c) { const int st = (r >> 4) * 2 + (c >> 5), rr = r & 15, cc = c & 31, ob = rr * 64 + cc * 2; return st * 1024 + (ob ^ (((ob >> 9) & 1) << 5)); }
__host__ __device__ __forceinline__ void stage_rc(int b, int& R, int& C) { const int st = b / 1024, sb = b % 1024, swz = sb ^ (((sb >> 9) & 1) << 5); R = (st >> 1) * 16 + swz / 64; C = (st & 1) * 32 + (swz % 64) / 2; }
__host__ __device__ __forceinline__ int perm32(int rho) { const int n = rho >> 4, i = rho & 15; return 8 * (i >> 2) + 4 * n + (i & 3); }

__device__ __forceinline__ void glds16_sv(const void* sbase, unsigned voff, unsigned lds_dst) {
    unsigned keep;
    asm volatile("s_mov_b32 %0, m0\n\ts_mov_b32 m0, %2\n\ts_nop 0\n\tglobal_load_lds_dwordx4 %1, %3\n\ts_mov_b32 m0, %0" : "=&s"(keep) : "v"(voff), "s"(lds_dst), "s"(sbase) : "memory");
}
struct Unit { int pm, pn; const char* B; int e, mt, nval, slot0; };

template <class Epi, class Sched, class AMap, bool ALIGN_EPI, bool FP8>
__device__ __forceinline__ void gemm_phase(LAS unsigned char* lds, const char* Abase, const int KB, const Sched& S, const AMap& AM, const Epi& E) {
    const int tid = threadIdx.x, wid = __builtin_amdgcn_readfirstlane(tid >> 6), lane = tid & 63, wr = wid >> 2, wc = wid & 3, fr = lane & 15, fq = lane >> 4;
    const int nt = KB / 128;
    int RA[2], CA[2]; unsigned voffB[2];
#pragma unroll
    for (int i = 0; i < 2; ++i) { int R, C; stage_rc(tid * 16 + i * 8192, R, C); const int Rb = Epi::PERM ? ((R & ~31) + perm32(R & 31)) : R;
        RA[i] = R; CA[i] = C; voffB[i] = (unsigned)(Rb * KB + C * 2); }
    const size_t kstep = (size_t)(BK * 2);
    const size_t hstep = (size_t)HALF * KB;
    const unsigned ldsw = (unsigned)wid * 1024u, ldsb = (unsigned)(size_t)lds;
    const int aoff = lds_byte(wr * 64 + fr, fq * 8), boff = lds_byte(wc * 32 + fr, fq * 8);
#define PG8_SA(b, h) (((b) * 2 + (h)) * HTB)
#define PG8_SB(b, h) ((4 + (b) * 2 + (h)) * HTB)
#define PG8_STAGE(bufoff, gbase, voff) do { _Pragma("unroll") for (int _i = 0; _i < 2; ++_i) \
        glds16_sv((const void*)(gbase), (voff)[_i], (unsigned)__builtin_amdgcn_readfirstlane((int)(ldsb + (unsigned)(bufoff) + ldsw + (unsigned)_i * 8192u))); } while (0)
#define PG8_LD8(p) __builtin_shufflevector(*(const LAS v4i_t*)(p), *(const LAS v4i_t*)((p) + 1024), 0, 1, 2, 3, 4, 5, 6, 7)
#define PG8_LDA(dst, b, h) do { _Pragma("unroll") for (int m = 0; m < 4; ++m) dst[m] = PG8_LD8(lds + PG8_SA(b, h) + aoff + m * 2048); } while (0)
#define PG8_LDB(dst, b, h) do { _Pragma("unroll") for (int n = 0; n < 2; ++n) dst[n] = PG8_LD8(lds + PG8_SB(b, h) + boff + n * 2048); } while (0)
#define PG8_HALF(v, k) __builtin_bit_cast(bf16x8, __builtin_shufflevector(v, v, 4 * (k), 4 * (k) + 1, 4 * (k) + 2, 4 * (k) + 3))
#define PG8_MMA(ai, bj, At, Bt) do { __builtin_amdgcn_s_setprio(1); _Pragma("unroll") for (int m = 0; m < 4; ++m) _Pragma("unroll") for (int n = 0; n < 2; ++n) { \
        if constexpr (FP8) asm volatile("v_mfma_scale_f32_16x16x128_f8f6f4 %0, %1, %2, %0, %3, %3 op_sel_hi:[0,0,0]" : "+v"(acc[ai][bj][m][n]) : "v"(Bt[n]), "v"(At[m]), "v"(scl1)); \
        else { acc[ai][bj][m][n] = __builtin_amdgcn_mfma_f32_16x16x32_bf16(PG8_HALF(Bt[n], 0), PG8_HALF(At[m], 0), acc[ai][bj][m][n], 0, 0, 0); \
               acc[ai][bj][m][n] = __builtin_amdgcn_mfma_f32_16x16x32_bf16(PG8_HALF(Bt[n], 1), PG8_HALF(At[m], 1), acc[ai][bj][m][n], 0, 0, 0); } } __builtin_amdgcn_s_setprio(0); } while (0)
#define PG8_WAIT_V(n) asm volatile("s_waitcnt vmcnt(" #n ")" ::: "memory")
#define PG8_WAIT_L(n) asm volatile("s_waitcnt lgkmcnt(" #n ")" ::: "memory")
#define PG8_BAR __builtin_amdgcn_s_barrier()
#define PG8_SCHED __builtin_amdgcn_sched_barrier(0)
    Unit cur, nxt; int ui = 0;
    if (!S.next(0, cur)) return;
    int scl1 = 0x7F7F7F7F; asm volatile("" : "+v"(scl1));
    f32x4 acc[2][2][4][2];
#pragma unroll
    for (int a = 0; a < 2; ++a)
#pragma unroll
        for (int b = 0; b < 2; ++b)
#pragma unroll
            for (int m = 0; m < 4; ++m)
#pragma unroll
                for (int n = 0; n < 2; ++n) acc[a][b][m][n] = (f32x4){0.f, 0.f, 0.f, 0.f};
    v8i_t At[4], B0[2], B1[2];
    unsigned cA0[2], cA1[2], nA0[2], nA1[2];
    AM.offs(cur, RA, CA, cA0, cA1);
    const char* cB = cur.B;
    PG8_STAGE(PG8_SB(0, 0), cB, voffB); PG8_STAGE(PG8_SB(0, 1), cB + hstep, voffB); PG8_STAGE(PG8_SA(0, 0), Abase, cA0); PG8_STAGE(PG8_SA(0, 1), Abase, cA1);
    if (wr == 1) PG8_BAR;
    PG8_WAIT_V(2); PG8_BAR;
    PG8_STAGE(PG8_SB(1, 0), cB + kstep, voffB); PG8_STAGE(PG8_SA(1, 0), Abase + kstep, cA0); PG8_STAGE(PG8_SB(1, 1), cB + hstep + kstep, voffB);
    PG8_WAIT_V(6); PG8_BAR;
    for (;;) {
        const bool has_next = S.next(ui + 1, nxt);
        if (has_next) AM.offs(nxt, RA, CA, nA0, nA1); else { nA0[0] = cA0[0]; nA0[1] = cA0[1]; nA1[0] = cA1[0]; nA1[1] = cA1[1]; }
        const char* nB = has_next ? nxt.B : cB;
        asm volatile("" : "+v"(nA0[0]), "+v"(nA0[1]), "+v"(nA1[0]), "+v"(nA1[1]));
        for (int t = 0; t < nt; t += 2) {
            const bool last = (t == nt - 2);
            const char* a1 = Abase + (size_t)(t + 1) * kstep;
            const char* a2 = last ? Abase : Abase + (size_t)(t + 2) * kstep;
            const char* b2 = last ? nB : cB + (size_t)(t + 2) * kstep;
            const char* a3 = a2 + kstep; const char* b3 = b2 + kstep;
            unsigned x0[2], x1[2];
            x0[0] = last ? nA0[0] : cA0[0]; x0[1] = last ? nA0[1] : cA0[1]; x1[0] = last ? nA1[0] : cA1[0]; x1[1] = last ? nA1[1] : cA1[1];
            PG8_LDB(B0, 0, 0); PG8_LDB(B1, 0, 1); PG8_SCHED; PG8_LDA(At, 0, 0); PG8_STAGE(PG8_SA(1, 1), a1, cA1);
            PG8_WAIT_V(8); PG8_WAIT_L(0); PG8_BAR; PG8_MMA(0, 0, At, B0); PG8_MMA(0, 1, At, B1); PG8_BAR; PG8_SCHED;
            PG8_LDA(At, 0, 1); PG8_STAGE(PG8_SB(0, 0), b2, voffB); PG8_STAGE(PG8_SB(0, 1), b2 + hstep, voffB); PG8_STAGE(PG8_SA(0, 0), a2, x0);
            PG8_WAIT_V(8); PG8_WAIT_L(0); PG8_BAR; PG8_MMA(1, 0, At, B0); PG8_MMA(1, 1, At, B1); PG8_BAR; PG8_SCHED;
            PG8_LDB(B0, 1, 0); PG8_LDB(B1, 1, 1); PG8_SCHED; PG8_LDA(At, 1, 0); PG8_STAGE(PG8_SA(0, 1), a2, x1);
            PG8_WAIT_V(8); PG8_WAIT_L(0); PG8_BAR; PG8_MMA(0, 0, At, B0); PG8_MMA(0, 1, At, B1); PG8_BAR; PG8_SCHED;
            PG8_LDA(At, 1, 1); PG8_STAGE(PG8_SB(1, 0), b3, voffB); PG8_STAGE(PG8_SB(1, 1), b3 + hstep, voffB); PG8_STAGE(PG8_SA(1, 0), a3, x0);
            PG8_WAIT_V(8); PG8_WAIT_L(0); PG8_BAR; PG8_MMA(1, 0, At, B0); PG8_MMA(1, 1, At, B1); PG8_BAR; PG8_SCHED;
        }
        if constexpr (ALIGN_EPI) { if (wr == 0) PG8_BAR; }
        if constexpr (FP8) asm volatile("s_nop 15\n\ts_nop 15" ::: "memory");
        E(acc, cur, wr, wc, fr, fq);
        if (!has_next) break;
#pragma unroll
        for (int a = 0; a < 2; ++a)
#pragma unroll
            for (int b = 0; b < 2; ++b)
#pragma unroll
                for (int m = 0; m < 4; ++m)
#pragma unroll
                    for (int n = 0; n < 2; ++n) acc[a][b][m][n] = (f32x4){0.f, 0.f, 0.f, 0.f};
        cur = nxt; cB = nB; cA0[0] = nA0[0]; cA0[1] = nA0[1]; cA1[0] = nA1[0]; cA1[1] = nA1[1]; ++ui;
        if constexpr (ALIGN_EPI) { if (wr == 1) PG8_BAR; }
    }
    PG8_WAIT_V(0);
    if constexpr (!ALIGN_EPI) { if (wr == 0) PG8_BAR; }
    PG8_BAR;
#undef PG8_SA
#undef PG8_SB
#undef PG8_STAGE
#undef PG8_LDA
#undef PG8_LDB
#undef PG8_LD8
#undef PG8_HALF
#undef PG8_MMA
#undef PG8_WAIT_V
#undef PG8_WAIT_L
#undef PG8_BAR
#undef PG8_SCHED
}

struct DenseOrder {
    int nM, nN, nwg, G, c; const char* Bt; size_t tstep;
    __device__ void init(int nM_, int nN_, int G_, int c_, const void* Bt_, int KB) { nM = nM_; nN = nN_; nwg = nM * nN; G = G_; c = c_; Bt = (const char*)Bt_; tstep = (size_t)256 * KB; }
    __device__ __forceinline__ bool next(int i, Unit& u) const {
        const long L = (long)i * G + c; if (L >= nwg) return false;
        int wgid = (int)L; { const int q = nwg / 8, r = nwg % 8, xcd = wgid % 8, off = wgid / 8; wgid = (xcd < r ? xcd * (q + 1) : r * (q + 1) + (xcd - r) * q) + off; }
        const int nig = 8 * nN, gid = wgid / nig, fm = gid * 8, gsz = (nM - fm) < 8 ? (nM - fm) : 8;
        u.pm = fm + ((wgid % nig) % gsz); u.pn = (wgid % nig) / gsz; u.B = Bt + (size_t)u.pn * tstep; u.e = 0; u.mt = 0; u.nval = 256; u.slot0 = u.pm * 256; return true;
    }
};
struct DenseA {
    int KB;
    __device__ __forceinline__ void offs(const Unit& u, const int (&RA)[2], const int (&CA)[2], unsigned (&o0)[2], unsigned (&o1)[2]) const {
#pragma unroll
        for (int i = 0; i < 2; ++i) { o0[i] = (unsigned)((u.pm * 256 + RA[i]) * KB + CA[i] * 2); o1[i] = (unsigned)((u.pm * 256 + 128 + RA[i]) * KB + CA[i] * 2); }
    }
};
struct MoeOrder {
    const LAS int* tp; const LAS int* cb; int NPN, G, c; const char* W; size_t estride, tstep;
    __device__ __forceinline__ bool next(int i, Unit& u) const {
#define RFL(x) __builtin_amdgcn_readfirstlane(x)
        const int L = i * G + c; const int total = RFL(tp[NE]) * NPN; if (L >= total) return false;
        int e = 0;
        while (e < NE - 1 && RFL(tp[e + 1]) * NPN <= L) ++e;
        const int tpe = RFL(tp[e]), tpe1 = RFL(tp[e + 1]), cbe = RFL(cb[e]), cbe1 = RFL(cb[e + 1]);
        const int loc = L - tpe * NPN, tl = tpe1 - tpe;
        u.e = e; u.mt = loc % tl; u.pn = loc / tl; u.pm = 0; const int cnt = cbe1 - cbe;
        const int rem = cnt - u.mt * 256; u.nval = rem < 256 ? rem : 256; u.slot0 = cbe + u.mt * 256;
        u.B = W + (size_t)e * estride + (size_t)u.pn * tstep; return true;
#undef RFL
    }
};
struct GatherA {
    const int* list; int KB;
    __device__ __forceinline__ void offs(const Unit& u, const int (&RA)[2], const int (&CA)[2], unsigned (&o0)[2], unsigned (&o1)[2]) const {
#pragma unroll
        for (int i = 0; i < 2; ++i) {
            const int r0 = RA[i], r1 = 128 + RA[i];
            const int t0 = r0 < u.nval ? list[u.e * TOK2 + u.mt * 256 + r0] : 0, t1 = r1 < u.nval ? list[u.e * TOK2 + u.mt * 256 + r1] : 0;
            o0[i] = (unsigned)(t0 * KB + CA[i] * 2); o1[i] = (unsigned)(t1 * KB + CA[i] * 2); }
    }
};
struct SlotA {
    int KB;
    __device__ __forceinline__ void offs(const Unit& u, const int (&RA)[2], const int (&CA)[2], unsigned (&o0)[2], unsigned (&o1)[2]) const {
#pragma unroll
        for (int i = 0; i < 2; ++i) { o0[i] = (unsigned)((u.slot0 + RA[i]) * KB + CA[i] * 2); o1[i] = (unsigned)((u.slot0 + 128 + RA[i]) * KB + CA[i] * 2); }
    }
};

struct EpiBf16 {
    static constexpr bool PERM = true;
    bf16_t* O; int ldc;
    __device__ __forceinline__ void operator()(const f32x4 (&acc)[2][2][4][2], const Unit& u, int wr, int wc, int fr, int fq) const {
        const int row0 = u.pm * BM + wr * 64 + fr, col0 = u.pn * BM + wc * 32 + 8 * fq;
#pragma unroll
        for (int ai = 0; ai < 2; ++ai)
#pragma unroll
            for (int m = 0; m < 4; ++m) { bf16_t* rowp = O + (size_t)(row0 + ai * HALF + m * 16) * ldc + col0;
#pragma unroll
                for (int bj = 0; bj < 2; ++bj) { const f32x4 v0 = acc[ai][bj][m][0], v1 = acc[ai][bj][m][1];
                    u32x4 w; w.x = pk2(v0[0], v0[1]); w.y = pk2(v0[2], v0[3]); w.z = pk2(v1[0], v1[1]); w.w = pk2(v1[2], v1[3]);
                    *(u32x4*)(rowp + bj * HALF) = w; } }
    }
};
template <bool ADD> struct EpiGate {
    static constexpr bool PERM = true;
    bf16_t* MG; const bf16_t* P; int gcol;
    __device__ __forceinline__ void operator()(const f32x4 (&acc)[2][2][4][2], const Unit& u, int wr, int wc, int fr, int fq) const {
        const int row0 = u.pm * BM + wr * 64 + fr, col0 = u.pn * BM + wc * 32 + 8 * fq;
#pragma unroll
        for (int ai = 0; ai < 2; ++ai)
#pragma unroll
            for (int m = 0; m < 4; ++m) { const size_t row = (size_t)(row0 + ai * HALF + m * 16);
#pragma unroll
                for (int bj = 0; bj < 2; ++bj) { const int col = col0 + bj * HALF;
                    const u32x4 g = *(const u32x4*)(P + row * DINP + gcol + col);
                    f32x4 v0 = acc[ai][bj][m][0], v1 = acc[ai][bj][m][1];
                    v0[0] *= sigmoidf_(bflo(g.x)); v0[1] *= sigmoidf_(bfhi(g.x)); v0[2] *= sigmoidf_(bflo(g.y)); v0[3] *= sigmoidf_(bfhi(g.y));
                    v1[0] *= sigmoidf_(bflo(g.z)); v1[1] *= sigmoidf_(bfhi(g.z)); v1[2] *= sigmoidf_(bflo(g.w)); v1[3] *= sigmoidf_(bfhi(g.w));
                    bf16_t* op = MG + row * DM + col;
                    if (ADD) { const u32x4 o = *(const u32x4*)op;
                        v0[0] += bflo(o.x); v0[1] += bfhi(o.x); v0[2] += bflo(o.y); v0[3] += bfhi(o.y); v1[0] += bflo(o.z); v1[1] += bfhi(o.z); v1[2] += bflo(o.w); v1[3] += bfhi(o.w); }
                    u32x4 w; w.x = pk2(v0[0], v0[1]); w.y = pk2(v0[2], v0[3]); w.z = pk2(v1[0], v1[1]); w.w = pk2(v1[2], v1[3]);
                    *(u32x4*)op = w; } }
    }
};
struct EpiResid {
    static constexpr bool PERM = false;
    const float* x; float* out;
    __device__ __forceinline__ void operator()(const f32x4 (&acc)[2][2][4][2], const Unit& u, int wr, int wc, int fr, int fq) const {
        const int row0 = u.pm * BM + wr * 64 + fr, col0 = u.pn * BM + wc * 32 + 4 * fq;
#pragma unroll
        for (int ai = 0; ai < 2; ++ai)
#pragma unroll
            for (int m = 0; m < 4; ++m) { const int row = row0 + ai * HALF + m * 16; const int b = row / LL, l = row - b * LL;
                if (row < TROWS && l >= NMETA) { const size_t off = (size_t)(b * SEQ + l - NMETA) * DM + col0;
#pragma unroll
                    for (int bj = 0; bj < 2; ++bj)
#pragma unroll
                        for (int n = 0; n < 2; ++n) { const f32x4 hv = *(const f32x4*)(x + off + bj * HALF + n * 16); *(f32x4*)(out + off + bj * HALF + n * 16) = acc[ai][bj][m][n] + hv; } } }
    }
};
__device__ __forceinline__ unsigned pk4_fp8(float a, float b, float c, float d) { int w = 0; w = __builtin_amdgcn_cvt_pk_fp8_f32(a, b, w, false); w = __builtin_amdgcn_cvt_pk_fp8_f32(c, d, w, true); return (unsigned)w; }
struct EpiSwiglu {
    static constexpr bool PERM = true;
    unsigned char* HID; const float* bg; const float* bu;
    __device__ __forceinline__ void operator()(const f32x4 (&acc)[2][2][4][2], const Unit& u, int wr, int wc, int fr, int fq) const {
        const int f0 = u.pn * 128 + wc * 32 + 8 * fq; const float dq = 1.0f / (SC_X * SC_W);
        const f32x4 g0 = *(const f32x4*)(bg + u.e * DFF + f0), g1 = *(const f32x4*)(bg + u.e * DFF + f0 + 4), u0 = *(const f32x4*)(bu + u.e * DFF + f0), u1 = *(const f32x4*)(bu + u.e * DFF + f0 + 4);
#pragma unroll
        for (int ai = 0; ai < 2; ++ai)
#pragma unroll
            for (int m = 0; m < 4; ++m) { const int r = ai * HALF + wr * 64 + m * 16 + fr;
                if (r < u.nval) {
                    float hv[8];
#pragma unroll
                    for (int n = 0; n < 2; ++n) { const f32x4 gg = acc[ai][0][m][n] * dq + (n ? g1 : g0), uu = acc[ai][1][m][n] * dq + (n ? u1 : u0);
#pragma unroll
                        for (int j = 0; j < 4; ++j) { const float gt = fminf(gg[j], 7.0f), up = fminf(fmaxf(uu[j], -7.0f), 7.0f);
                            hv[4 * n + j] = SC_H * (up + 1.0f) * gt * __builtin_amdgcn_rcpf(1.0f + __builtin_amdgcn_exp2f(-1.702f * LOG2E * gt)); } }
                    *(u32x2*)(HID + (size_t)(u.slot0 + r) * DFF + f0) = (u32x2){pk4_fp8(hv[0], hv[1], hv[2], hv[3]), pk4_fp8(hv[4], hv[5], hv[6], hv[7])}; } }
    }
};
struct EpiDown {
    static constexpr bool PERM = true;
    bf16_t* Y; const float* bd; const float* glist;
    __device__ __forceinline__ void operator()(const f32x4 (&acc)[2][2][4][2], const Unit& u, int wr, int wc, int fr, int fq) const {
        const int col0 = u.pn * BM + wc * 32 + 8 * fq; const float dq = 1.0f / (SC_H * SC_W);
        f32x4 bv[2][2];
#pragma unroll
        for (int bj = 0; bj < 2; ++bj)
#pragma unroll
            for (int n = 0; n < 2; ++n) bv[bj][n] = *(const f32x4*)(bd + u.e * DM + col0 + bj * HALF + 4 * n);
#pragma unroll
        for (int ai = 0; ai < 2; ++ai)
#pragma unroll
            for (int m = 0; m < 4; ++m) { const int r = ai * HALF + wr * 64 + m * 16 + fr;
                if (r < u.nval) { const float gw = glist[u.e * TOK2 + u.mt * 256 + r];
#pragma unroll
                    for (int bj = 0; bj < 2; ++bj) { const f32x4 v0 = (acc[ai][bj][m][0] * dq + bv[bj][0]) * gw, v1 = (acc[ai][bj][m][1] * dq + bv[bj][1]) * gw;
                        u32x4 w; w.x = pk2(v0[0], v0[1]); w.y = pk2(v0[2], v0[3]); w.z = pk2(v1[0], v1[1]); w.w = pk2(v1[2], v1[3]);
                        *(u32x4*)(Y + (size_t)(u.slot0 + r) * DM + col0 + bj * HALF) = w; } } }
    }
};
}

struct Args { const float* in[19]; float* out; unsigned char* ws; int ph_lo, ph_hi; };
struct Frame {
    LAS unsigned char* lds; gu32* ctl; int tid, lane, wave, G, vcu;
};
#define MFMA32(a, b, c) __builtin_amdgcn_mfma_f32_32x32x16_bf16((a), (b), (c), 0, 0, 0)
__device__ __forceinline__ int crow(int reg, int h) { return (reg & 3) + 8 * (reg >> 2) + 4 * h; }

template <bool F8> __device__ __forceinline__ void p0_transpose_item(const float* W, int K, int N, void* WTv, int dst_row0, int k0, int n0, LAS float* scr, int lane) {
    const int nn = n0 + (lane & 31); const bool ok = nn < N;
    float v[32];
#pragma unroll
    for (int i = 0; i < 32; ++i) { const int kk = 2 * i + (lane >> 5); v[i] = ok ? __builtin_nontemporal_load(W + (size_t)(k0 + kk) * N + nn) : 0.f; }
#pragma unroll
    for (int i = 0; i < 32; ++i) { const int kk = 2 * i + (lane >> 5); scr[kk * 33 + (lane & 31)] = v[i]; }
    LDS_WAIT(); asm volatile("" ::: "memory");
    if constexpr (F8) {
        unsigned char* WT = (unsigned char*)WTv; const int c = lane & 3;
#pragma unroll
        for (int j = 0; j < 2; ++j) { const int n = (lane >> 2) + 16 * j; const LAS float* s = scr + (16 * c) * 33 + n;
            u32x4 o; o.x = pg8::pk4_fp8(s[0 * 33] * SC_W, s[1 * 33] * SC_W, s[2 * 33] * SC_W, s[3 * 33] * SC_W); o.y = pg8::pk4_fp8(s[4 * 33] * SC_W, s[5 * 33] * SC_W, s[6 * 33] * SC_W, s[7 * 33] * SC_W);
            o.z = pg8::pk4_fp8(s[8 * 33] * SC_W, s[9 * 33] * SC_W, s[10 * 33] * SC_W, s[11 * 33] * SC_W); o.w = pg8::pk4_fp8(s[12 * 33] * SC_W, s[13 * 33] * SC_W, s[14 * 33] * SC_W, s[15 * 33] * SC_W);
            if (n0 + n < N) *(u32x4*)(WT + (size_t)(dst_row0 + n) * K + k0 + 16 * c) = o; }
    } else {
        bf16_t* WT = (bf16_t*)WTv; const int c = lane & 7;
#pragma unroll
        for (int j = 0; j < 4; ++j) { const int n = (lane >> 3) + 8 * j; const LAS float* s = scr + (8 * c) * 33 + n;
            u32x4 o; o.x = pk2(s[0 * 33], s[1 * 33]); o.y = pk2(s[2 * 33], s[3 * 33]); o.z = pk2(s[4 * 33], s[5 * 33]); o.w = pk2(s[6 * 33], s[7 * 33]);
            if (n0 + n < N) *(u32x4*)(WT + (size_t)(dst_row0 + n) * K + k0 + 8 * c) = o; }
    }
    LDS_WAIT(); asm volatile("" ::: "memory");
}
__device__ __forceinline__ void p0_prologue(const Frame& F, const Args& a) {
    unsigned char* ws = a.ws;
    LAS float* scr = (LAS float*)(F.lds + F.wave * 16384);
    const int gw = F.vcu * NWAVES + F.wave, NGW = F.G * NWAVES, lane = F.lane;
    {
        const float* x = a.in[0]; const float* meta = a.in[1]; const float* g = a.in[2]; bf16_t* XN = (bf16_t*)(ws + WS_XN);
        f32x4 gv[8];
#pragma unroll
        for (int j = 0; j < 8; ++j) gv[j] = ((const f32x4*)g)[lane + 64 * j];
        for (int r = gw; r < MPAD; r += NGW) {
            unsigned long long* o8 = (unsigned long long*)(XN + (size_t)r * DM) + lane;
            if (r >= TROWS) {
#pragma unroll
                for (int j = 0; j < 8; ++j) o8[64 * j] = 0ull;
                continue; }
            const int b = r / LL, l = r - b * LL;
            const f32x4* src = (const f32x4*)(l < NMETA ? meta + (size_t)l * DM : x + (size_t)(b * SEQ + l - NMETA) * DM) + lane;
            f32x4 v[8]; float s = 0.f;
#pragma unroll
            for (int j = 0; j < 8; ++j) { v[j] = src[64 * j]; s += (v[j].x * v[j].x + v[j].y * v[j].y) + (v[j].z * v[j].z + v[j].w * v[j].w); }
            const float rstd = 1.0f / sqrtf(wave_sum(s) * (1.0f / DM) + EPS);
#pragma unroll
            for (int j = 0; j < 8; ++j) { const f32x4 y = v[j] * rstd * gv[j]; o8[64 * j] = (unsigned long long)pk2(y.x, y.y) | ((unsigned long long)pk2(y.z, y.w) << 32); }
        }
    }
    {
        float* rope = (float*)(ws + WS_ROPE);
        for (int it = gw * 64 + lane; it < LL * 8; it += NGW * 64) { const int pos = it >> 3, j = it & 7;
            const float fr = (float)pow(500000.0, -(double)j / 8.0); const float ang = (float)pos * fr;
            rope[pos * 16 + j] = (float)cos((double)ang); rope[pos * 16 + 8 + j] = (float)sin((double)ang); }
    }
    {
        const float* pw = a.in[4]; const float* ps = a.in[5]; const float* wbp = a.in[6]; bf16_t* WE = (bf16_t*)(ws + WS_WEFF);
        for (int it = gw; it < 4 * 64 * 32; it += NGW) { const int g = it >> 11, c4 = (it >> 5) & 63, nb = it & 31, n = nb * 64 + lane;
            float acc0 = 0.f, acc1 = 0.f, acc2 = 0.f, acc3 = 0.f; const float* pr = pw + (size_t)(g * 256 + c4 * 4) * 256;
            for (int d = 0; d < 256; ++d) { const float wv = wbp[(size_t)(g * 256 + d) * DM + n] * ps[g * 256 + d];
                acc0 += pr[d] * wv; acc1 += pr[256 + d] * wv; acc2 += pr[512 + d] * wv; acc3 += pr[768 + d] * wv; }
            *(u32x2*)(WE + (size_t)n * 1024 + g * 256 + c4 * 4) = (u32x2){pk2(acc0, acc1), pk2(acc2, acc3)}; }
    }
    {
        constexpr int I_IN = 32 * 291, I_BA = 16 * 64, I_OUT = 32 * 64, I_EXP = 32 * 64;
        constexpr int NITEMS = I_IN + I_BA + I_OUT + NE * 3 * I_EXP;
        for (int it = gw; it < NITEMS; it += NGW) {
            int r = it;
            if (r < I_IN) { const int kb = r / 291, nb = r % 291; p0_transpose_item<false>(a.in[3], DM, DIN, (bf16_t*)(ws + WS_WIN), nb * 32, kb * 64, nb * 32, scr, lane); continue; } r -= I_IN;
            if (r < I_BA) { const int kb = r / 64, nb = r % 64; p0_transpose_item<false>(a.in[7], 1024, DM, (bf16_t*)(ws + WS_WBA), nb * 32, kb * 64, nb * 32, scr, lane); continue; } r -= I_BA;
            if (r < I_OUT) { const int kb = r / 64, nb = r % 64; p0_transpose_item<false>(a.in[8], DM, DM, (bf16_t*)(ws + WS_WOUT), nb * 32, kb * 64, nb * 32, scr, lane); continue; } r -= I_OUT;
            const int e = r / (3 * I_EXP), rr = r % (3 * I_EXP), mat = rr / I_EXP, q = rr % I_EXP, kb = q / 64, nb = q % 64, n0 = nb * 32;
            if (mat == 0) p0_transpose_item<true>(a.in[12] + (size_t)e * DM * DFF, DM, DFF, (ws + WS_WGU) + (size_t)e * 4096 * DM, (n0 >> 7) * 256 + (n0 & 127), kb * 64, n0, scr, lane);
            else if (mat == 1) p0_transpose_item<true>(a.in[14] + (size_t)e * DM * DFF, DM, DFF, (ws + WS_WGU) + (size_t)e * 4096 * DM, (n0 >> 7) * 256 + 128 + (n0 & 127), kb * 64, n0, scr, lane);
            else p0_transpose_item<true>(a.in[16] + (size_t)e * DFF * DM, DFF, DM, (ws + WS_WD) + (size_t)e * DM * DFF, n0, kb * 64, n0, scr, lane);
        }
    }
}

__device__ __forceinline__ void p2_elementwise(const Frame& F, const Args& a) {
    unsigned char* ws = a.ws; bf16_t* P = (bf16_t*)(ws + WS_P); bf16_t* POOL = (bf16_t*)(ws + WS_POOL); bf16_t* VT = (bf16_t*)(ws + WS_VT); const float* rope = (const float*)(ws + WS_ROPE);
    const int tid = F.tid, lane = F.lane, wave = F.wave;
    for (int unit = F.vcu; unit < NB * 65; unit += F.G) {
        const int b = unit / 65, st = unit % 65, l0 = st * 64, nl = (LL - l0) < 64 ? (LL - l0) : 64;
        const size_t rowb = (size_t)b * LL;
        {
            const int w = 2 << (tid >> 7); float s0 = 0.f, s1 = 0.f;
            for (int i = (l0 - w > 0 ? l0 - w : 0); i < l0; ++i) { const unsigned v = *(const unsigned*)(P + (rowb + i) * DINP + C_U + 2 * tid); s0 += bflo(v); s1 += bfhi(v); }
            for (int l = l0; l < l0 + nl; ++l) {
                const unsigned v = *(const unsigned*)(P + (rowb + l) * DINP + C_U + 2 * tid); const float u0 = bflo(v), u1 = bfhi(v);
                s0 += u0; s1 += u1;
                if (l - w >= 0) { const unsigned o = *(const unsigned*)(P + (rowb + l - w) * DINP + C_U + 2 * tid); s0 -= bflo(o); s1 -= bfhi(o); }
                const float ic = 1.0f / (float)((l + 1) < w ? (l + 1) : w);
                *(unsigned*)(POOL + (rowb + l) * 1024 + 2 * tid) = pk2(s0 * ic - u0, s1 * ic - u1);
            }
        }
        for (int it = tid; it < nl * 49; it += NTHR) {
            const int rl = it / 49, hs = it % 49, l = l0 + rl;
            const int col = hs < 16 ? C_Q + hs * 64 : (hs < 32 ? C_K + (hs - 16) * 64 : (hs < 48 ? C_IQ + (hs - 32) * 64 : C_IK));
            bf16_t* p = P + (rowb + l) * DINP + col;
            const u32x4 x1 = *(const u32x4*)p, x2 = *(const u32x4*)(p + 8);
            const f32x4 c0 = *(const f32x4*)(rope + l * 16), c1 = *(const f32x4*)(rope + l * 16 + 4), s0 = *(const f32x4*)(rope + l * 16 + 8), s1 = *(const f32x4*)(rope + l * 16 + 12);
            const float a0 = bflo(x1.x), a1 = bfhi(x1.x), a2 = bflo(x1.y), a3 = bfhi(x1.y), a4 = bflo(x1.z), a5 = bfhi(x1.z), a6 = bflo(x1.w), a7 = bfhi(x1.w);
            const float b0 = bflo(x2.x), b1 = bfhi(x2.x), b2 = bflo(x2.y), b3 = bfhi(x2.y), b4 = bflo(x2.z), b5 = bfhi(x2.z), b6 = bflo(x2.w), b7 = bfhi(x2.w);
            u32x4 o1, o2;
            o1.x = pk2(a0 * c0.x - b0 * s0.x, a1 * c0.y - b1 * s0.y); o1.y = pk2(a2 * c0.z - b2 * s0.z, a3 * c0.w - b3 * s0.w);
            o1.z = pk2(a4 * c1.x - b4 * s1.x, a5 * c1.y - b5 * s1.y); o1.w = pk2(a6 * c1.z - b6 * s1.z, a7 * c1.w - b7 * s1.w);
            o2.x = pk2(b0 * c0.x + a0 * s0.x, b1 * c0.y + a1 * s0.y); o2.y = pk2(b2 * c0.z + a2 * s0.z, b3 * c0.w + a3 * s0.w);
            o2.z = pk2(b4 * c1.x + a4 * s1.x, b5 * c1.y + a5 * s1.y); o2.w = pk2(b6 * c1.z + a6 * s1.z, b7 * c1.w + a7 * s1.w);
            *(u32x4*)p = o1; *(u32x4*)(p + 8) = o2;
        }
        for (int hh = 0; hh < 2; ++hh) {
            const int hd = 2 * wave + hh; const int l = l0 + lane;
            u32x4 v[8];
            if (l < LL) {
#pragma unroll
                for (int j = 0; j < 8; ++j) v[j] = *(const u32x4*)(P + (rowb + l) * DINP + C_V + hd * 64 + 8 * j);
            } else {
#pragma unroll
                for (int j = 0; j < 8; ++j) v[j] = (u32x4){0u, 0u, 0u, 0u};
            }
            bf16_t* dst = VT + (size_t)((b * NH + hd) * 64) * KPAD + l;
#pragma unroll
            for (int j = 0; j < 8; ++j) {
                dst[(size_t)(8 * j + 0) * KPAD] = (bf16_t)(v[j].x & 0xffffu); dst[(size_t)(8 * j + 1) * KPAD] = (bf16_t)(v[j].x >> 16);
                dst[(size_t)(8 * j + 2) * KPAD] = (bf16_t)(v[j].y & 0xffffu); dst[(size_t)(8 * j + 3) * KPAD] = (bf16_t)(v[j].y >> 16);
                dst[(size_t)(8 * j + 4) * KPAD] = (bf16_t)(v[j].z & 0xffffu); dst[(size_t)(8 * j + 5) * KPAD] = (bf16_t)(v[j].z >> 16);
                dst[(size_t)(8 * j + 6) * KPAD] = (bf16_t)(v[j].w & 0xffffu); dst[(size_t)(8 * j + 7) * KPAD] = (bf16_t)(v[j].w >> 16);
            }
        }
    }
}

constexpr int SC_PITCH = 4160;
__device__ __forceinline__ unsigned f2key(float f) { const unsigned u = __float_as_uint(f); return u ^ ((unsigned)((int)u >> 31) | 0x80000000u); }
template <int NR> __device__ __forceinline__ void select_row(const LAS float* scrow, const int n, const int lane, unsigned long long* mrow) {
    unsigned key[NR];
#pragma unroll
    for (int i = 0; i < NR; ++i) { const int k = 64 * i + lane; key[i] = k < n ? f2key(scrow[k]) : 0u; }
    unsigned Pfx = 0u; bool exact = false;
    for (int bit = 31; bit >= 0; --bit) {
        const unsigned cand = Pfx | (1u << bit); int c = 0;
#pragma unroll
        for (int i = 0; i < NR; ++i) c += __builtin_popcountll(__ballot(key[i] >= cand));
        if (c >= NSEL) { Pfx = cand; if (c == NSEL) { exact = true; break; } }
    }
    unsigned long long myw = 0ull, myw2 = 0ull;
    if (exact) {
#pragma unroll
        for (int i = 0; i < NR; ++i) { const unsigned long long bl = __ballot(key[i] >= Pfx); if (i < 64) { if (lane == i) myw = bl; } else { if (lane == 0) myw2 = bl; } }
    } else {
        int g = 0;
#pragma unroll
        for (int i = 0; i < NR; ++i) g += __builtin_popcountll(__ballot(key[i] > Pfx));
        const int need = NSEL - g; int run = 0;
#pragma unroll
        for (int i = 0; i < NR; ++i) { const bool eq = key[i] == Pfx; const unsigned long long be = __ballot(eq);
            const int rank = run + __builtin_amdgcn_mbcnt_hi((unsigned)(be >> 32), __builtin_amdgcn_mbcnt_lo((unsigned)be, 0u));
            const bool sel = (key[i] > Pfx) || (eq && rank < need);
            const unsigned long long bl = __ballot(sel); run += __builtin_popcountll(be);
            if (i < 64) { if (lane == i) myw = bl; } else { if (lane == 0) myw2 = bl; } }
    }
    mrow[lane] = myw;
    if (lane == 0) mrow[64] = myw2;
    if (lane == 1) mrow[65] = 0ull;
}
__device__ __forceinline__ void p3_select(const Frame& F, const Args& a, const int tw) {
    unsigned char* ws = a.ws; const bf16_t* P = (const bf16_t*)(ws + WS_P); unsigned long long* MASK = (unsigned long long*)(ws + WS_MASK);
    LAS float* sc = (LAS float*)F.lds; volatile LAS int* tick = (volatile LAS int*)(F.lds + LDSCTL_OFF + 64);
    const int lane = F.lane, wave = F.wave, r32 = lane & 31, hh = lane >> 5;
    for (;;) {
        __syncthreads();
        if (F.tid == 0) tick[0] = (int)__hip_atomic_fetch_add(F.ctl + CW_TICKET + 64 * tw, 1u, RLX_AGENT);
        __syncthreads();
        const int ui = tick[0];
        if (ui >= NB * 512) break;
        const int grp = 513 - ui / NB, b = ui % NB, l0 = grp * 8;
        const size_t rowb = (size_t)b * LL;
        const int q = l0 + wave;
        if (l0 >= NSEL) {
            const int pr = wave & 3, par = wave >> 2, qa = l0 + 2 * pr;
            const int ntl = (l0 + 8 + 31) >> 5;
            bf16x8 af[4]; float sg[16];
            {
                const int qq = qa + ((r32 >> 2) & 1), head = (r32 >> 3) * 4 + (r32 & 3);
                const bf16_t* qrow = P + (rowb + qq) * DINP;
                const float wsc = fabsf(bf2f(qrow[C_IW + head])) * 0.03125f;
#pragma unroll
                for (int c = 0; c < 4; ++c) { const u32x4 v = *(const u32x4*)(qrow + C_IQ + head * 64 + 16 * c + 8 * hh); u32x4 o;
                    o.x = pk2(bflo(v.x) * wsc, bfhi(v.x) * wsc); o.y = pk2(bflo(v.y) * wsc, bfhi(v.y) * wsc); o.z = pk2(bflo(v.z) * wsc, bfhi(v.z) * wsc); o.w = pk2(bflo(v.w) * wsc, bfhi(v.w) * wsc);
                    af[c] = __builtin_bit_cast(bf16x8, o); }
                const bf16_t* wrow = P + (rowb + qa + hh) * DINP + C_IW;
                const u32x4 w0 = *(const u32x4*)wrow, w1 = *(const u32x4*)(wrow + 8);
                const unsigned ww[8] = {w0.x, w0.y, w0.z, w0.w, w1.x, w1.y, w1.z, w1.w};
#pragma unroll
                for (int i = 0; i < 8; ++i) { sg[2 * i] = bflo(ww[i]) < 0.f ? -1.f : 1.f; sg[2 * i + 1] = bfhi(ww[i]) < 0.f ? -1.f : 1.f; }
            }
            LAS unsigned char* ikst = F.lds + IKST_OFF;
            const int nch = (ntl + 3) >> 2;
            const bf16_t* ksrc = P + (rowb + (F.tid >> 3)) * DINP + C_IK + (F.tid & 7) * 8;
            u32x4 R[4][2];
#pragma unroll
            for (int j = 0; j < 4; ++j) { const bf16_t* kn = ksrc + (size_t)(128 * (j < nch ? j : 0)) * DINP; R[j][0] = *(const u32x4*)kn; R[j][1] = *(const u32x4*)(kn + (size_t)64 * DINP); }
            for (int ch0 = 0; ch0 < nch; ch0 += 4) {
#pragma unroll
                for (int j = 0; j < 4; ++j) {
                    const int ch = ch0 + j;
                    if (ch < nch) {
                        __syncthreads();
                        *(LAS u32x4*)(ikst + (F.tid >> 3) * 144 + (F.tid & 7) * 16) = R[j][0]; *(LAS u32x4*)(ikst + (64 + (F.tid >> 3)) * 144 + (F.tid & 7) * 16) = R[j][1];
                        if (ch + 4 < nch) { const bf16_t* kn = ksrc + (size_t)(128 * (ch + 4)) * DINP; R[j][0] = *(const u32x4*)kn; R[j][1] = *(const u32x4*)(kn + (size_t)64 * DINP); }
                        __syncthreads();
#pragma unroll
                        for (int tsk = 0; tsk < 2; ++tsk) {
                            const int tic = par + 2 * tsk, t = 4 * ch + tic;
                            if (t < ntl) {
                                f32x16 z = {};
#pragma unroll
                                for (int c = 0; c < 4; ++c) { const bf16x8 bfrag = *(const LAS bf16x8*)(ikst + (32 * tic + r32) * 144 + (16 * c + 8 * hh) * 2); z = MFMA32(af[c], bfrag, z); }
                                float s0 = 0.f, s1 = 0.f;
#pragma unroll
                                for (int i = 0; i < 16; i += 2) { s0 += sg[i] * fmaxf(z[i], 0.f); s1 += sg[i + 1] * fmaxf(z[i + 1], 0.f); }
                                sc[(2 * pr + hh) * SC_PITCH + 32 * t + r32] = s0 + s1;
                            }
                        }
                    }
                }
            }
        }
        __syncthreads();
        unsigned long long* mrow = MASK + (rowb + q) * MASKW;
        if (l0 < NSEL) {
            for (int i = lane; i < MASKW; i += 64) { const int lo = 64 * i; unsigned long long wv = 0ull;
                if (lo + 63 <= q) wv = ~0ull; else if (lo <= q) wv = (~0ull) >> (63 - (q - lo));
                mrow[i] = wv; }
        } else {
            const int n = q + 1; const LAS float* scrow = sc + wave * SC_PITCH;
            const int nr = (n + 63) >> 6;
#if DBL == 31
            if (nr <= 8) select_row<8>(scrow, n, lane, mrow);
            else if (nr <= 16) select_row<16>(scrow, n, lane, mrow);
            else if (nr <= 24) select_row<24>(scrow, n, lane, mrow);
            else if (nr <= 32) select_row<32>(scrow, n, lane, mrow);
            else if (nr <= 40) select_row<40>(scrow, n, lane, mrow);
            else if (nr <= 48) select_row<48>(scrow, n, lane, mrow);
            else if (nr <= 56) select_row<56>(scrow, n, lane, mrow);
            else select_row<65>(scrow, n, lane, mrow);
#endif
            if (nr <= 8) select_row<8>(scrow, n, lane, mrow);
            else if (nr <= 16) select_row<16>(scrow, n, lane, mrow);
            else if (nr <= 24) select_row<24>(scrow, n, lane, mrow);
            else if (nr <= 32) select_row<32>(scrow, n, lane, mrow);
            else if (nr <= 40) select_row<40>(scrow, n, lane, mrow);
            else if (nr <= 48) select_row<48>(scrow, n, lane, mrow);
            else if (nr <= 56) select_row<56>(scrow, n, lane, mrow);
            else select_row<65>(scrow, n, lane, mrow);
        }
    }
}

constexpr int KV_PITCH = 72;
constexpr int KV_TILE = 64 * KV_PITCH * 2;
__device__ __forceinline__ void p4_attention(const Frame& F, const Args& a, const int tw) {
    unsigned char* ws = a.ws; const bf16_t* P = (const bf16_t*)(ws + WS_P); const bf16_t* VT = (const bf16_t*)(ws + WS_VT); bf16_t* O = (bf16_t*)(ws + WS_O);
    const unsigned long long* MASK = (const unsigned long long*)(ws + WS_MASK);
    LAS unsigned char* lds = F.lds; volatile LAS int* tick = (volatile LAS int*)(F.lds + LDSCTL_OFF + 64);
    const int tid = F.tid, lane = F.lane, wave = F.wave, r32 = lane & 31, hh = lane >> 5;
    const int srow = tid >> 3, sch = tid & 7;
    const float CS = 0.125f * LOG2E;
    for (;;) {
        __syncthreads();
        if (tid == 0) tick[0] = (int)__hip_atomic_fetch_add(F.ctl + CW_TICKET + 64 * tw, 1u, RLX_AGENT);
        __syncthreads();
        const int ui = tick[0];
        if (ui >= NB * NH * 17) break;
        const int jb = 16 - ui / (NB * NH), bh = ui % (NB * NH), b = bh / NH, hd = bh % NH;
        const int q_lo = jb == 0 ? 0 : 16 + 256 * (jb - 1), nrows = jb == 0 ? 16 : 256, q_hi = q_lo + nrows - 1, nt = q_hi / 64 + 1;
        const size_t rowb = (size_t)b * LL;
        const int qrel = 32 * wave + r32; int q = q_lo + qrel; const bool qvalid = qrel < nrows; if (q > LL - 1) q = LL - 1;
        const int qmax_w = q_lo + 32 * wave + 31;
        bf16x8 qf[4];
#pragma unroll
        for (int c = 0; c < 4; ++c) qf[c] = *(const bf16x8*)(P + (rowb + q) * DINP + C_Q + hd * 64 + 16 * c + 8 * hh);
        const unsigned long long* mq = MASK + (rowb + q) * MASKW;
        const bf16_t* kbase = P + rowb * DINP + C_K + hd * 64 + sch * 8;
        const bf16_t* vbase = VT + (size_t)((b * NH + hd) * 64 + srow) * KPAD + sch * 8;
        f32x16 o0 = {}, o1 = {}; float m = -1e30f, lsum = 0.f;
        u32x4 kreg = *(const u32x4*)(kbase + (size_t)srow * DINP), vreg = *(const u32x4*)(vbase);
        *(LAS u32x4*)(lds + srow * (KV_PITCH * 2) + sch * 16) = kreg; *(LAS u32x4*)(lds + KV_TILE + srow * (KV_PITCH * 2) + sch * 16) = vreg;
        __syncthreads();
        for (int kt = 0; kt < nt; ++kt) {
            const int buf = kt & 1; LAS unsigned char* Kl = lds + buf * 2 * KV_TILE; LAS unsigned char* Vl = Kl + KV_TILE;
            if (kt + 1 < nt) { kreg = *(const u32x4*)(kbase + (size_t)(64 * (kt + 1) + srow) * DINP); vreg = *(const u32x4*)(vbase + 64 * (kt + 1)); }
            if (64 * kt <= qmax_w) {
                f32x16 p0 = {}, p1 = {};
#pragma unroll
                for (int c = 0; c < 4; ++c) {
                    const bf16x8 k0 = *(const LAS bf16x8*)(Kl + r32 * (KV_PITCH * 2) + (16 * c + 8 * hh) * 2);
                    const bf16x8 k1 = *(const LAS bf16x8*)(Kl + (32 + r32) * (KV_PITCH * 2) + (16 * c + 8 * hh) * 2);
                    p0 = MFMA32(k0, qf[c], p0); p1 = MFMA32(k1, qf[c], p1); }
                const unsigned long long mw = mq[kt]; const unsigned wlo = (unsigned)mw >> (4 * hh), whi = (unsigned)(mw >> 32) >> (4 * hh);
                float mx = -INFINITY;
#pragma unroll
                for (int i = 0; i < 16; ++i) { const int bp = (i & 3) + 8 * (i >> 2);
                    p0[i] = ((wlo >> bp) & 1u) ? p0[i] * CS : -INFINITY; p1[i] = ((whi >> bp) & 1u) ? p1[i] * CS : -INFINITY;
                    mx = fmaxf(mx, fmaxf(p0[i], p1[i])); }
                mx = fmaxf(mx, __shfl_xor(mx, 32));
                const float mn = fmaxf(m, mx), alpha = __builtin_amdgcn_exp2f(m - mn); m = mn;
                float ps = 0.f;
#pragma unroll
                for (int i = 0; i < 16; ++i) { p0[i] = __builtin_amdgcn_exp2f(p0[i] - mn); p1[i] = __builtin_amdgcn_exp2f(p1[i] - mn); ps += p0[i] + p1[i]; }
                lsum = lsum * alpha + ps;
#pragma unroll
                for (int i = 0; i < 16; ++i) { o0[i] *= alpha; o1[i] *= alpha; }
#pragma unroll
                for (int blk = 0; blk < 2; ++blk)
#pragma unroll
                    for (int s = 0; s < 2; ++s) {
                        u32x4 pw;
                        if (blk == 0) { pw.x = pk2(p0[8 * s], p0[8 * s + 1]); pw.y = pk2(p0[8 * s + 2], p0[8 * s + 3]); pw.z = pk2(p0[8 * s + 4], p0[8 * s + 5]); pw.w = pk2(p0[8 * s + 6], p0[8 * s + 7]); }
                        else { pw.x = pk2(p1[8 * s], p1[8 * s + 1]); pw.y = pk2(p1[8 * s + 2], p1[8 * s + 3]); pw.z = pk2(p1[8 * s + 4], p1[8 * s + 5]); pw.w = pk2(p1[8 * s + 6], p1[8 * s + 7]); }
                        const bf16x8 pf = __builtin_bit_cast(bf16x8, pw);
                        const int kofs = (blk * 32 + 16 * s + 4 * hh) * 2;
                        {   const s16x4 va = *(const LAS s16x4*)(Vl + r32 * (KV_PITCH * 2) + kofs), vb = *(const LAS s16x4*)(Vl + r32 * (KV_PITCH * 2) + kofs + 16);
                            const bf16x8 vf = __builtin_shufflevector(va, vb, 0, 1, 2, 3, 4, 5, 6, 7); o0 = MFMA32(vf, pf, o0); }
                        {   const s16x4 va = *(const LAS s16x4*)(Vl + (32 + r32) * (KV_PITCH * 2) + kofs), vb = *(const LAS s16x4*)(Vl + (32 + r32) * (KV_PITCH * 2) + kofs + 16);
                            const bf16x8 vf = __builtin_shufflevector(va, vb, 0, 1, 2, 3, 4, 5, 6, 7); o1 = MFMA32(vf, pf, o1); }
                    }
            }
            if (kt + 1 < nt) { LAS unsigned char* Kn = lds + (buf ^ 1) * 2 * KV_TILE;
                *(LAS u32x4*)(Kn + srow * (KV_PITCH * 2) + sch * 16) = kreg; *(LAS u32x4*)(Kn + KV_TILE + srow * (KV_PITCH * 2) + sch * 16) = vreg; }
            __syncthreads();
        }
        const float lt = lsum + __shfl_xor(lsum, 32); const float inv = 1.0f / lt;
        if (qvalid) {
            bf16_t* orow = O + (rowb + q) * 1024 + hd * 64;
#pragma unroll
            for (int g = 0; g < 4; ++g) {
                *(u32x2*)(orow + 8 * g + 4 * hh) = (u32x2){pk2(o0[4 * g] * inv, o0[4 * g + 1] * inv), pk2(o0[4 * g + 2] * inv, o0[4 * g + 3] * inv)};
                *(u32x2*)(orow + 32 + 8 * g + 4 * hh) = (u32x2){pk2(o1[4 * g] * inv, o1[4 * g + 1] * inv), pk2(o1[4 * g + 2] * inv, o1[4 * g + 3] * inv)}; }
        }
    }
}

__device__ __forceinline__ void p7_router(const Frame& F, const Args& a) {
    unsigned char* ws = a.ws; const float* H1 = a.out; unsigned char* XN2 = ws + WS_XN;
    const float* g2 = a.in[9]; const float* rw = a.in[10]; const float* rb = a.in[11];
    int* tok_e = (int*)(ws + WS_ROUTE + RT_TOKE); int* tok_p = (int*)(ws + WS_ROUTE + RT_TOKP); int* list = (int*)(ws + WS_ROUTE + RT_LIST); float* glist = (float*)(ws + WS_ROUTE + RT_GLIST);
    LAS float* xs = (LAS float*)F.lds;
    LAS float* wsm = xs + 128 * 68;
    LAS float* lg = wsm + 64 * 32;
    LAS float* rs = lg + 128 * 33;
    LAS int* hist = (LAS int*)(rs + 128);
    LAS int* gbase = hist + 32;
    const int tid = F.tid, lane = F.lane, wave = F.wave;
    for (int tile = F.vcu; tile < TOK2 / 128; tile += F.G) {
        const int t0 = tile * 128;
        const int tt = tid & 63, eg = tid >> 6;
        float acc[2][4] = {{0.f, 0.f, 0.f, 0.f}, {0.f, 0.f, 0.f, 0.f}}; float ssq0 = 0.f, ssq1 = 0.f;
        if (tid < 32) hist[tid] = 0;
        for (int kc = 0; kc < DM / 64; ++kc) {
            __syncthreads();
#pragma unroll
            for (int j = 0; j < 4; ++j) { const int idx = tid + 512 * j, row = idx >> 4, c4 = idx & 15;
                *(LAS f32x4*)(xs + row * 68 + c4 * 4) = *(const f32x4*)(H1 + (size_t)(t0 + row) * DM + kc * 64 + c4 * 4); }
            { const int d = tid >> 3, e4 = tid & 7; const f32x4 wv = *(const f32x4*)(rw + (size_t)(kc * 64 + d) * NE + e4 * 4); *(LAS f32x4*)(wsm + d * 32 + e4 * 4) = wv * g2[kc * 64 + d]; }
            __syncthreads();
#pragma unroll 4
            for (int k4 = 0; k4 < 16; ++k4) {
                const f32x4 xa = *(const LAS f32x4*)(xs + tt * 68 + 4 * k4), xb = *(const LAS f32x4*)(xs + (tt + 64) * 68 + 4 * k4);
#pragma unroll
                for (int kk = 0; kk < 4; ++kk) { const f32x4 wv = *(const LAS f32x4*)(wsm + (4 * k4 + kk) * 32 + 4 * eg);
#pragma unroll
                    for (int j = 0; j < 4; ++j) { acc[0][j] += xa[kk] * wv[j]; acc[1][j] += xb[kk] * wv[j]; }
                    ssq0 += xa[kk] * xa[kk]; ssq1 += xb[kk] * xb[kk]; }
            }
        }
        const float r0 = 1.0f / sqrtf(ssq0 * (1.0f / DM) + EPS), r1 = 1.0f / sqrtf(ssq1 * (1.0f / DM) + EPS);
#pragma unroll
        for (int j = 0; j < 4; ++j) { lg[tt * 33 + 4 * eg + j] = acc[0][j] * r0 + rb[4 * eg + j]; lg[(tt + 64) * 33 + 4 * eg + j] = acc[1][j] * r1 + rb[4 * eg + j]; }
        if (eg == 0) { rs[tt] = r0; rs[tt + 64] = r1; }
        __syncthreads();
        int te[4], tl[4]; float tg[4];
        if (tid < 128) {
            float v[32];
#pragma unroll
            for (int e = 0; e < 32; ++e) v[e] = lg[tid * 33 + e];
            float tv[4];
#pragma unroll
            for (int k = 0; k < 4; ++k) { float best = -INFINITY; int bi = 0;
#pragma unroll
                for (int e = 0; e < 32; ++e) { const bool tk = v[e] > best; best = tk ? v[e] : best; bi = tk ? e : bi; }
                tv[k] = best; te[k] = bi;
#pragma unroll
                for (int e = 0; e < 32; ++e) v[e] = (e == bi) ? -INFINITY : v[e]; }
            const float e1 = __expf(tv[1] - tv[0]), e2 = __expf(tv[2] - tv[0]), e3 = __expf(tv[3] - tv[0]); const float inv = 1.0f / (1.0f + e1 + e2 + e3);
            tg[0] = inv; tg[1] = e1 * inv; tg[2] = e2 * inv; tg[3] = e3 * inv;
#pragma unroll
            for (int k = 0; k < 4; ++k) tl[k] = atomicAdd((int*)&hist[te[k]], 1);
        }
        __syncthreads();
        if (tid < 32) gbase[tid] = (int)__hip_atomic_fetch_add(F.ctl + CW_CURSOR + tid, (unsigned)hist[tid], RLX_AGENT);
        __syncthreads();
        if (tid < 128) {
            const int t2 = t0 + tid;
#pragma unroll
            for (int k = 0; k < 4; ++k) { const int pos = gbase[te[k]] + tl[k]; list[te[k] * TOK2 + pos] = t2; glist[te[k] * TOK2 + pos] = tg[k]; tok_e[t2 * 4 + k] = te[k]; tok_p[t2 * 4 + k] = pos; }
        }
        f32x4 gv[8];
#pragma unroll
        for (int j = 0; j < 8; ++j) gv[j] = ((const f32x4*)g2)[lane + 64 * j];
        for (int rr = 0; rr < 16; ++rr) { const int row = wave * 16 + rr; const float rstd = rs[row];
            const f32x4* src = (const f32x4*)(H1 + (size_t)(t0 + row) * DM) + lane; unsigned* o4 = (unsigned*)(XN2 + (size_t)(t0 + row) * DM) + lane;
#pragma unroll
            for (int j = 0; j < 8; ++j) { const f32x4 y = src[64 * j] * (rstd * SC_X) * gv[j]; o4[64 * j] = pg8::pk4_fp8(y.x, y.y, y.z, y.w); } }
        __syncthreads();
    }
}

__device__ __forceinline__ void moe_tables(const Frame& F, LAS int* tp, LAS int* cb) {
    __syncthreads();
    if (F.tid == 0) { int t = 0, c = 0;
        for (int e = 0; e < NE; ++e) { tp[e] = t; cb[e] = c; const int n = (int)__hip_atomic_load(F.ctl + CW_CURSOR + e, RLX_AGENT); t += (n + 255) >> 8; c += n; }
        tp[NE] = t; cb[NE] = c; }
    __syncthreads();
}

__device__ __forceinline__ void p11_combine(const Frame& F, const Args& a, const LAS int* cb) {
    unsigned char* ws = a.ws; float* out = a.out; const bf16_t* Y = (const bf16_t*)(ws + WS_Y); const float* gf = a.in[18];
    const int* tok_e = (const int*)(ws + WS_ROUTE + RT_TOKE); const int* tok_p = (const int*)(ws + WS_ROUTE + RT_TOKP);
    const int gw = F.vcu * NWAVES + F.wave, NGW = F.G * NWAVES, lane = F.lane;
    f32x4 gv[8];
#pragma unroll
    for (int j = 0; j < 8; ++j) gv[j] = ((const f32x4*)gf)[lane + 64 * j];
    for (int t2 = gw; t2 < TOK2; t2 += NGW) {
        f32x4* row = (f32x4*)(out + (size_t)t2 * DM) + lane;
        f32x4 v[8];
#pragma unroll
        for (int j = 0; j < 8; ++j) v[j] = row[64 * j];
#pragma unroll
        for (int k = 0; k < 4; ++k) { const int e = tok_e[t2 * 4 + k], slot = cb[e] + tok_p[t2 * 4 + k];
            const u32x2* yr = (const u32x2*)(Y + (size_t)slot * DM) + lane;
#pragma unroll
            for (int j = 0; j < 8; ++j) { const u32x2 w = yr[64 * j]; v[j].x += bflo(w.x); v[j].y += bfhi(w.x); v[j].z += bflo(w.y); v[j].w += bfhi(w.y); } }
        float s = 0.f;
#pragma unroll
        for (int j = 0; j < 8; ++j) s += (v[j].x * v[j].x + v[j].y * v[j].y) + (v[j].z * v[j].z + v[j].w * v[j].w);
        const float rstd = 1.0f / sqrtf(wave_sum(s) * (1.0f / DM) + EPS);
#pragma unroll
        for (int j = 0; j < 8; ++j) row[64 * j] = v[j] * rstd * gv[j];
    }
}

constexpr int NPHASE = 11;
__global__ void __launch_bounds__(NTHR, 2) fwd_kernel(Args args) {
    extern __shared__ __attribute__((aligned(16))) unsigned char lds_raw[];
    Frame F;
    F.lds = (LAS unsigned char*)lds_raw;
    F.tid = threadIdx.x; F.lane = F.tid & 63; F.wave = __builtin_amdgcn_readfirstlane(F.tid >> 6);
    F.G = gridDim.x; { const int bx = blockIdx.x; F.vcu = (F.G % 8 == 0) ? (bx % 8) * (F.G / 8) + bx / 8 : bx; }
    unsigned char* ws = args.ws;
    F.ctl = (gu32*)(ws + WS_CTL);
    for (int u = F.tid; u < (LDS_BYTES - LDSCTL_OFF) / 4; u += NTHR) ((LAS unsigned*)(F.lds + LDSCTL_OFF))[u] = 0u;
    __syncthreads();
    volatile LAS unsigned* MISC = (volatile LAS unsigned*)(F.lds + LDSCTL_OFF);
    LAS int* tp = (LAS int*)(F.lds + LDSCTL_OFF + 256); LAS int* cb = tp + 40;
    const int lo = args.ph_lo, hi = args.ph_hi;
    const bool one = (hi - lo) > 1;
    XcdBarrier bar; bar.bar = (unsigned*)(F.ctl + CW_BAR); bar.x = 0; bar.st = nullptr;
    if (one) bar = xcd_barrier_post((unsigned*)(F.ctl + CW_BAR), MISC + 8);
#ifndef PH_MASK
#define PH_MASK 0x7ff
#endif
#define IN(k) ((((PH_MASK) >> (k)) & 1) && lo <= (k) && (k) < hi)
#define SEAM(k) do { if (IN(k) && IN((k) + 1)) xcd_barrier(bar); } while (0)
    const int G = F.G, cid = (int)blockIdx.x;

    if (IN(0)) { p0_prologue(F, args);
#if DBL == 0
        p0_prologue(F, args);
#endif
    } SEAM(0);

    if (IN(1)) {
        pg8::DenseOrder S; S.init(MPAD / 256, DINP / 256, G, cid, ws + WS_WIN, DM * 2); pg8::DenseA AM{DM * 2}; pg8::EpiBf16 E{(bf16_t*)(ws + WS_P), DINP};
        pg8::gemm_phase<pg8::EpiBf16, pg8::DenseOrder, pg8::DenseA, true, false>(F.lds, (const char*)(ws + WS_XN), DM * 2, S, AM, E);
    } SEAM(1);

    if (IN(2)) { p2_elementwise(F, args); } SEAM(2);

    if (IN(3)) {
        pg8::DenseOrder S; S.init(MPAD / 256, DM / 256, G, cid, ws + WS_WEFF, 2048); pg8::DenseA AM{2048}; pg8::EpiGate<false> E{(bf16_t*)(ws + WS_MG), (const bf16_t*)(ws + WS_P), C_GP};
        pg8::gemm_phase<pg8::EpiGate<false>, pg8::DenseOrder, pg8::DenseA, true, false>(F.lds, (const char*)(ws + WS_POOL), 2048, S, AM, E);
        p3_select(F, args, 0);
#if DBL == 3
        p3_select(F, args, 2);
#endif
    } SEAM(3);

    if (IN(4)) { p4_attention(F, args, 1);
#if DBL == 4
        p4_attention(F, args, 3);
#endif
    } SEAM(4);

    if (IN(5)) {
        pg8::DenseOrder S; S.init(MPAD / 256, DM / 256, G, cid, ws + WS_WBA, 2048); pg8::DenseA AM{2048}; pg8::EpiGate<true> E{(bf16_t*)(ws + WS_MG), (const bf16_t*)(ws + WS_P), C_GA};
        pg8::gemm_phase<pg8::EpiGate<true>, pg8::DenseOrder, pg8::DenseA, true, false>(F.lds, (const char*)(ws + WS_O), 2048, S, AM, E);
    } SEAM(5);

    if (IN(6)) {
        pg8::DenseOrder S; S.init(MPAD / 256, DM / 256, G, cid, ws + WS_WOUT, DM * 2); pg8::DenseA AM{DM * 2}; pg8::EpiResid E{args.in[0], args.out};
        pg8::gemm_phase<pg8::EpiResid, pg8::DenseOrder, pg8::DenseA, true, false>(F.lds, (const char*)(ws + WS_MG), DM * 2, S, AM, E);
    } SEAM(6);

    if (IN(7)) { p7_router(F, args); } SEAM(7);

    if (IN(8)) {
        moe_tables(F, tp, cb);
        pg8::MoeOrder S{tp, cb, 16, G, cid, (const char*)(ws + WS_WGU), (size_t)4096 * DM, (size_t)256 * DM};
        pg8::GatherA AM{(const int*)(ws + WS_ROUTE + RT_LIST), DM}; pg8::EpiSwiglu E{ws + WS_HID, args.in[13], args.in[15]};
        pg8::gemm_phase<pg8::EpiSwiglu, pg8::MoeOrder, pg8::GatherA, true, true>(F.lds, (const char*)(ws + WS_XN), DM, S, AM, E);
    } SEAM(8);

    if (IN(9)) {
        moe_tables(F, tp, cb);
        pg8::MoeOrder S{tp, cb, 8, G, cid, (const char*)(ws + WS_WD), (size_t)DM * DFF, (size_t)256 * DFF};
        pg8::SlotA AM{DFF}; pg8::EpiDown E{(bf16_t*)(ws + WS_Y), args.in[17], (const float*)(ws + WS_ROUTE + RT_GLIST)};
        pg8::gemm_phase<pg8::EpiDown, pg8::MoeOrder, pg8::SlotA, true, true>(F.lds, (const char*)(ws + WS_HID), DFF, S, AM, E);
    } SEAM(9);

    if (IN(10)) { moe_tables(F, tp, cb); p11_combine(F, args, cb); }
#undef IN
#undef SEAM
}

extern "C" void kernel_launch(void* const* d_in, const int* in_sizes, int n_in, void* d_out, int out_size, void* d_ws, size_t ws_size, hipStream_t stream) {
    static int grid = 0;
    if (grid == 0) {
        if (n_in != 19 || out_size != TOK2 * DM || ws_size < WS_END) { fprintf(stderr, "kernel_launch: unexpected shapes (n_in %d out %d ws %zu)\n", n_in, out_size, ws_size); grid = -1; return; }
        int dev = 0, cus = 0, per_cu = 0;
        if (hipGetDevice(&dev) != hipSuccess || hipDeviceGetAttribute(&cus, hipDeviceAttributeMultiprocessorCount, dev) != hipSuccess) { grid = -1; return; }
        if (hipFuncSetAttribute((const void*)fwd_kernel, hipFuncAttributeMaxDynamicSharedMemorySize, LDS_BYTES) != hipSuccess) { fprintf(stderr, "kernel_launch: hipFuncSetAttribute failed\n"); grid = -1; return; }
        if (hipOccupancyMaxActiveBlocksPerMultiprocessor(&per_cu, (const void*)fwd_kernel, NTHR, LDS_BYTES) != hipSuccess || per_cu < 1) { fprintf(stderr, "kernel_launch: occupancy query says %d\n", per_cu); }
        (void)hipGetLastError();
        grid = cus;
    }
    if (grid < 0) return;
    if (hipMemsetAsync((char*)d_ws + WS_CTL, 0, CTL_ZERO_BYTES, stream) != hipSuccess) return;
    Args a{};
    for (int i = 0; i < 19; ++i) a.in[i] = (const float*)d_in[i];
    a.out = (float*)d_out; a.ws = (unsigned char*)d_ws;
#if MK_N_LAUNCHES == 1
    a.ph_lo = 0; a.ph_hi = NPHASE;
    hipLaunchKernelGGL(fwd_kernel, dim3(grid), dim3(NTHR), LDS_BYTES, stream, a);
#else
    for (int p = 0; p < NPHASE; ++p) { a.ph_lo = p; a.ph_hi = p + 1; hipLaunchKernelGGL(fwd_kernel, dim3(grid), dim3(NTHR), LDS_BYTES, stream, a); }
#endif
}
```

```cpp
#include <hip/hip_runtime.h>
#include <cstdio>
#include <cstdint>

#ifndef DBL
#define DBL -1
#endif
#ifndef MK_N_LAUNCHES
#define MK_N_LAUNCHES 1
#endif

#define GAS __attribute__((address_space(1)))
#define LAS __attribute__((address_space(3)))
typedef unsigned short bf16_t;
typedef short bf16x8 __attribute__((ext_vector_type(8)));
typedef short s16x4 __attribute__((ext_vector_type(4)));
typedef float f32x4 __attribute__((ext_vector_type(4)));
typedef float f32x16 __attribute__((ext_vector_type(16)));
typedef float f32x2 __attribute__((ext_vector_type(2)));
typedef __bf16 bf16x2_t __attribute__((ext_vector_type(2)));
typedef unsigned u32x4 __attribute__((ext_vector_type(4)));
typedef unsigned u32x2 __attribute__((ext_vector_type(2)));
typedef GAS unsigned gu32;
typedef _Float16 h2_t __attribute__((ext_vector_type(2)));
typedef int v4i_t __attribute__((ext_vector_type(4)));
typedef int v8i_t __attribute__((ext_vector_type(8)));

constexpr int DM = 2048, NB = 8, SEQ = 4096, NMETA = 16, LL = SEQ + NMETA;
constexpr int TROWS = NB * LL;
constexpr int MPAD = 33024;
constexpr int DIN = 9296, DINP = 9472;
constexpr int C_U = 0, C_Q = 1024, C_K = 2048, C_V = 3072, C_IQ = 4096, C_IK = 5120, C_IW = 5184, C_GP = 5200, C_GA = 7248;
constexpr int NH = 16, HD = 64, NE = 32, TOPK = 4, DFF = 2048;
constexpr int TOK2 = NB * SEQ;
constexpr int NASSIGN = TOK2 * TOPK;
constexpr int NSEL = 256;
constexpr int KPAD = 4160;
constexpr int MASKW = 66;
constexpr int NTK = KPAD / 32;
constexpr float EPS = 1e-5f;
constexpr float LOG2E = 1.4426950408889634f;

constexpr size_t MiB = 1u << 20;
constexpr size_t WS_CTL = 0, CTL_ZERO_BYTES = 1 * MiB;
constexpr size_t WS_ROPE = 1 * MiB;
constexpr size_t WS_ROUTE = 2 * MiB;
constexpr size_t RT_TOKE = 0, RT_TOKP = 1 * MiB, RT_LIST = 2 * MiB, RT_GLIST = 6 * MiB;
constexpr size_t WS_WIN = 12 * MiB;
constexpr size_t WS_WEFF = 49 * MiB;
constexpr size_t WS_WBA = 53 * MiB;
constexpr size_t WS_WOUT = 57 * MiB;
constexpr size_t WS_WGU = 65 * MiB;
constexpr size_t WS_WD = 321 * MiB;
constexpr size_t WS_XN = 449 * MiB;
constexpr size_t WS_P = 578 * MiB;
constexpr size_t WS_HID = WS_P;
constexpr size_t WS_POOL = 1175 * MiB;
constexpr size_t WS_O = 1240 * MiB;
constexpr size_t WS_MG = 1305 * MiB;
constexpr size_t WS_VT = 1434 * MiB;
constexpr size_t WS_MASK = 1499 * MiB;
constexpr size_t WS_Y = 1516 * MiB;
constexpr size_t WS_IKF = 2028 * MiB;
constexpr size_t WS_END = 2034 * MiB;
static_assert(WS_WIN + (size_t)DINP * DM * 2 <= WS_WEFF && WS_XN + (size_t)MPAD * DM * 2 <= WS_P && WS_P + (size_t)MPAD * DINP * 2 <= WS_POOL, "ws map");
static_assert(WS_HID + (size_t)(NASSIGN + 256) * DFF <= WS_POOL && WS_POOL + (size_t)MPAD * 1024 * 2 <= WS_O && WS_O + (size_t)MPAD * 1024 * 2 <= WS_MG, "ws map");
static_assert(WS_MG + (size_t)MPAD * DM * 2 <= WS_VT && WS_VT + (size_t)NB * NH * 64 * KPAD * 2 <= WS_MASK && WS_MASK + (size_t)NB * MASKW * KPAD * 8 <= WS_Y, "ws map");
static_assert(WS_WGU + (size_t)NE * 4096 * 2048 <= WS_WD && WS_WD + (size_t)NE * 2048 * 2048 <= WS_XN && WS_Y + (size_t)NASSIGN * DM * 2 <= WS_END, "ws map");
constexpr float SC_W = 2048.0f, SC_X = 16.0f, SC_H = 4.0f;

constexpr int CW_TMO = 0;
constexpr int CW_TICKET = 64;
constexpr int CW_CURSOR = 1024;
constexpr int CW_BAR = 4096;

constexpr int RING_BYTES = 131072;
constexpr int IKST_OFF = 133120;
constexpr int LDSCTL_OFF = 151552;
constexpr int LDS_BYTES = 159744;
constexpr int NWAVES = 8, NTHR = 512;

#define RLX_AGENT __ATOMIC_RELAXED, __HIP_MEMORY_SCOPE_AGENT
#define LDS_WAIT() asm volatile("s_waitcnt lgkmcnt(0)" ::: "memory")
#define VM_WAIT() asm volatile("s_waitcnt vmcnt(0)" ::: "memory")

__device__ __forceinline__ unsigned f2bf(float f) { unsigned u = __builtin_bit_cast(unsigned, f); return (u + 0x7fffu + ((u >> 16) & 1u)) >> 16; }
__device__ __forceinline__ unsigned pk2(float lo, float hi) { f32x2 v = {lo, hi}; bf16x2_t b = __builtin_convertvector(v, bf16x2_t); return __builtin_bit_cast(unsigned, b); }
__device__ __forceinline__ float bf2f(unsigned short x) { return __uint_as_float(((unsigned)x) << 16); }
__device__ __forceinline__ float bflo(unsigned w) { return __uint_as_float(w << 16); }
__device__ __forceinline__ float bfhi(unsigned w) { return __uint_as_float(w & 0xffff0000u); }
__device__ __forceinline__ float sigmoidf_(float x) { return __builtin_amdgcn_rcpf(1.0f + __builtin_amdgcn_exp2f(-LOG2E * x)); }
__device__ __forceinline__ float wave_sum(float v) {
#pragma unroll
    for (int o = 1; o < 64; o <<= 1) v += __shfl_xor(v, o);
    return v;
}
__device__ __forceinline__ int wave_sum_i(int v) {
#pragma unroll
    for (int o = 1; o < 64; o <<= 1) v += __shfl_xor(v, o);
    return v;
}

#define XB_TMO      128
#define XB_XCNT(j)  (256  + 64 * (j))
#define XB_XSUB(j)  (1280 + 64 * (j))
#define XB_XGEN(j)  (2304 + 64 * (j))
#define XB_TOP      3328
#define XB_TOPGEN   3392
#define XCD_BAR_WORDS 3456
#define XB_SPIN_CAP (1u << 22)

__device__ __forceinline__ unsigned xb_ld(unsigned* p)              { return __hip_atomic_load(p, __ATOMIC_RELAXED, __HIP_MEMORY_SCOPE_AGENT); }
__device__ __forceinline__ unsigned xb_add(unsigned* p, unsigned v) { return __hip_atomic_fetch_add(p, v, __ATOMIC_RELAXED, __HIP_MEMORY_SCOPE_AGENT); }
__device__ __forceinline__ unsigned xb_xcc_id() { return (unsigned)__builtin_amdgcn_s_getreg((3 << 11) | 20) & 0xFu; }
#define XB_SPIN(cond, bar) do { unsigned _sp = 0; while (cond) { __builtin_amdgcn_s_sleep(1); \
    if ((++_sp & 255u) == 0u) { if (xb_ld(&(bar)[XB_TMO])) break; if (_sp > XB_SPIN_CAP) { atomicAdd(&(bar)[XB_TMO], 1u); break; } } } } while (0)

struct XcdBarrier { unsigned* bar; unsigned x; volatile LAS unsigned* st; };

__device__ __forceinline__ XcdBarrier xcd_barrier_post(unsigned* bar, volatile LAS unsigned* st) {
    XcdBarrier b; b.bar = bar; b.x = xb_xcc_id(); b.st = st;
    if (threadIdx.x == 0) (void)xb_add(&bar[XB_XCNT(b.x)], 1u);
    return b;
}
__device__ __forceinline__ void xcd_barrier_complete(unsigned* bar, unsigned x, unsigned& nloc, unsigned& nx) {
    const unsigned G = gridDim.x * gridDim.y * gridDim.z;
    unsigned sum, cnt, mine, sp = 0u;
    for (;;) {
        sum = 0u; cnt = 0u; mine = 0u;
#pragma unroll
        for (unsigned j = 0; j < 16; ++j) { const unsigned c = xb_ld(&bar[XB_XCNT(j)]); sum += c; cnt += (c > 0u) ? 1u : 0u; mine = (j == x) ? c : mine; }
        if (sum == G) break;
        __builtin_amdgcn_s_sleep(1);
        if ((++sp & 255u) == 0u) { if (xb_ld(&bar[XB_TMO])) break; if (sp > XB_SPIN_CAP) { atomicAdd(&bar[XB_TMO], 1u); break; } }
    }
    nloc = mine > 0u ? mine : 1u; nx = cnt > 0u ? cnt : 1u;
}
__device__ __forceinline__ void xcd_barrier(const XcdBarrier& b) {
    asm volatile("s_waitcnt vmcnt(0)" ::: "memory");
    __syncthreads();
    if (threadIdx.x == 0) {
        unsigned* bar = b.bar;
        __builtin_amdgcn_s_waitcnt(0);
        unsigned nloc = b.st[0], nx = b.st[1];
        if (nloc == 0u) { xcd_barrier_complete(bar, b.x, nloc, nx); b.st[0] = nloc; b.st[1] = nx; }
        const unsigned old = xb_add(&bar[XB_XSUB(b.x)], 1u);
        const unsigned gen = old / nloc;
        if (old + 1u == (gen + 1u) * nloc) {
            __builtin_amdgcn_fence(__ATOMIC_RELEASE, "agent");
            asm volatile("s_waitcnt vmcnt(0)" ::: "memory");
            const unsigned og = xb_add(&bar[XB_TOP], 1u);
            const unsigned tg = og / nx;
            if (og + 1u == (tg + 1u) * nx) xb_add(&bar[XB_TOPGEN], 1u);
            else XB_SPIN(xb_ld(&bar[XB_TOPGEN]) == tg, bar);
            __builtin_amdgcn_fence(__ATOMIC_ACQUIRE, "agent");
            xb_add(&bar[XB_XGEN(b.x)], 1u);
            asm volatile("s_waitcnt vmcnt(0)" ::: "memory");
        } else {
            XB_SPIN(xb_ld(&bar[XB_XGEN(b.x)]) == gen, bar);
            __builtin_amdgcn_fence(__ATOMIC_ACQUIRE, "agent");
            asm volatile("s_waitcnt vmcnt(0)" ::: "memory");
        }
    }
    __syncthreads();
}

namespace pg8 {
constexpr int BM = 256, BK = 64, HALF = 128, HTB = HALF * BK * 2, STAGE_BYTES = 8 * HTB;
__host__ __device__ __forceinline__ int lds_byte(int r, int c) { const int st = (r >> 4) * 2 + (c >> 5), rr = r & 15, cc = c & 31, ob = rr * 64 + cc * 2; return st * 1024 + (ob ^ (((ob >> 9) & 1) << 5)); }
__host__ __device__ __forceinline__ void stage_rc(int b, int& R, int& C) { const int st = b / 1024, sb = b % 1024, swz = sb ^ (((sb >> 9) & 1) << 5); R = (st >> 1) * 16 + swz / 64; C = (st & 1) * 32 + (swz % 64) / 2; }
__host__ __device__ __forceinline__ int perm32(int rho) { const int n = rho >> 4, i = rho & 15; return 8 * (i >> 2) + 4 * n + (i & 3); }

__device__ __forceinline__ void glds16_sv(const void* sbase, unsigned voff, unsigned lds_dst) {
    unsigned keep;
    asm volatile("s_mov_b32 %0, m0\n\ts_mov_b32 m0, %2\n\ts_nop 0\n\tglobal_load_lds_dwordx4 %1, %3\n\ts_mov_b32 m0, %0" : "=&s"(keep) : "v"(voff), "s"(lds_dst), "s"(sbase) : "memory");
}
struct Unit { int pm, pn; const char* B; int e, mt, nval, slot0; };

template <class Epi, class Sched, class AMap, bool ALIGN_EPI, bool FP8>
__device__ __forceinline__ void gemm_phase(LAS unsigned char* lds, const char* Abase, const int KB, const Sched& S, const AMap& AM, const Epi& E) {
    const int tid = threadIdx.x, wid = __builtin_amdgcn_readfirstlane(tid >> 6), lane = tid & 63, wr = wid >> 2, wc = wid & 3, fr = lane & 15, fq = lane >> 4;
    const int nt = KB / 128;
    int RA[2], CA[2]; unsigned voffB[2];
#pragma unroll
    for (int i = 0; i < 2; ++i) { int R, C; stage_rc(tid * 16 + i * 8192, R, C); const int Rb = Epi::PERM ? ((R & ~31) + perm32(R & 31)) : R;
        RA[i] = R; CA[i] = C; voffB[i] = (unsigned)(Rb * KB + C * 2); }
    const size_t kstep = (size_t)(BK * 2);
    const size_t hstep = (size_t)HALF * KB;
    const unsigned ldsw = (unsigned)wid * 1024u, ldsb = (unsigned)(size_t)lds;
    const int aoff = lds_byte(wr * 64 + fr, fq * 8), boff = lds_byte(wc * 32 + fr, fq * 8);
#define PG8_SA(b, h) (((b) * 2 + (h)) * HTB)
#define PG8_SB(b, h) ((4 + (b) * 2 + (h)) * HTB)
#define PG8_STAGE(bufoff, gbase, voff) do { _Pragma("unroll") for (int _i = 0; _i < 2; ++_i) \
        glds16_sv((const void*)(gbase), (voff)[_i], (unsigned)__builtin_amdgcn_readfirstlane((int)(ldsb + (unsigned)(bufoff) + ldsw + (unsigned)_i * 8192u))); } while (0)
#define PG8_LD8(p) __builtin_shufflevector(*(const LAS v4i_t*)(p), *(const LAS v4i_t*)((p) + 1024), 0, 1, 2, 3, 4, 5, 6, 7)
#define PG8_LDA(dst, b, h) do { _Pragma("unroll") for (int m = 0; m < 4; ++m) dst[m] = PG8_LD8(lds + PG8_SA(b, h) + aoff + m * 2048); } while (0)
#define PG8_LDB(dst, b, h) do { _Pragma("unroll") for (int n = 0; n < 2; ++n) dst[n] = PG8_LD8(lds + PG8_SB(b, h) + boff + n * 2048); } while (0)
#define PG8_HALF(v, k) __builtin_bit_cast(bf16x8, __builtin_shufflevector(v, v, 4 * (k), 4 * (k) + 1, 4 * (k) + 2, 4 * (k) + 3))
#define PG8_MMA(ai, bj, At, Bt) do { __builtin_amdgcn_s_setprio(1); _Pragma("unroll") for (int m = 0; m < 4; ++m) _Pragma("unroll") for (int n = 0; n < 2; ++n) { \
        if constexpr (FP8) asm volatile("v_mfma_scale_f32_16x16x128_f8f6f4 %0, %1, %2, %0, %3, %3 op_sel_hi:[0,0,0]" : "+v"(acc[ai][bj][m][n]) : "v"(Bt[n]), "v"(At[m]), "v"(scl1)); \
        else { acc[ai][bj][m][n] = __builtin_amdgcn_mfma_f32_16x16x32_bf16(PG8_HALF(Bt[n], 0), PG8_HALF(At[m], 0), acc[ai][bj][m][n], 0, 0, 0); \
               acc[ai][bj][m][n] = __builtin_amdgcn_mfma_f32_16x16x32_bf16(PG8_HALF(Bt[n], 1), PG8_HALF(At[m], 1), acc[ai][bj][m][n], 0, 0, 0); } } __builtin_amdgcn_s_setprio(0); } while (0)
#define PG8_WAIT_V(n) asm volatile("s_waitcnt vmcnt(" #n ")" ::: "memory")
#define PG8_WAIT_L(n) asm volatile("s_waitcnt lgkmcnt(" #n ")" ::: "memory")
#define PG8_BAR __builtin_amdgcn_s_barrier()
#define PG8_SCHED __builtin_amdgcn_sched_barrier(0)
    Unit cur, nxt; int ui = 0;
    if (!S.next(0, cur)) return;
    int scl1 = 0x7F7F7F7F; asm volatile("" : "+v"(scl1));
    f32x4 acc[2][2][4][2];
#pragma unroll
    for (int a = 0; a < 2; ++a)
#pragma unroll
        for (int b = 0; b < 2; ++b)
#pragma unroll
            for (int m = 0; m < 4; ++m)
#pragma unroll
                for (int n = 0; n < 2; ++n) acc[a][b][m][n] = (f32x4){0.f, 0.f, 0.f, 0.f};
    v8i_t At[4], B0[2], B1[2];
    unsigned cA0[2], cA1[2], nA0[2], nA1[2];
    AM.offs(cur, RA, CA, cA0, cA1);
    const char* cB = cur.B;
    PG8_STAGE(PG8_SB(0, 0), cB, voffB); PG8_STAGE(PG8_SB(0, 1), cB + hstep, voffB); PG8_STAGE(PG8_SA(0, 0), Abase, cA0); PG8_STAGE(PG8_SA(0, 1), Abase, cA1);
    if (wr == 1) PG8_BAR;
    PG8_WAIT_V(2); PG8_BAR;
    PG8_STAGE(PG8_SB(1, 0), cB + kstep, voffB); PG8_STAGE(PG8_SA(1, 0), Abase + kstep, cA0); PG8_STAGE(PG8_SB(1, 1), cB + hstep + kstep, voffB);
    PG8_WAIT_V(6); PG8_BAR;
    for (;;) {
        const bool has_next = S.next(ui + 1, nxt);
        if (has_next) AM.offs(nxt, RA, CA, nA0, nA1); else { nA0[0] = cA0[0]; nA0[1] = cA0[1]; nA1[0] = cA1[0]; nA1[1] = cA1[1]; }
        const char* nB = has_next ? nxt.B : cB;
        asm volatile("" : "+v"(nA0[0]), "+v"(nA0[1]), "+v"(nA1[0]), "+v"(nA1[1]));
        for (int t = 0; t < nt; t += 2) {
            const bool last = (t == nt - 2);
            const char* a1 = Abase + (size_t)(t + 1) * kstep;
            const char* a2 = last ? Abase : Abase + (size_t)(t + 2) * kstep;
            const char* b2 = last ? nB : cB + (size_t)(t + 2) * kstep;
            const char* a3 = a2 + kstep; const char* b3 = b2 + kstep;
            unsigned x0[2], x1[2];
            x0[0] = last ? nA0[0] : cA0[0]; x0[1] = last ? nA0[1] : cA0[1]; x1[0] = last ? nA1[0] : cA1[0]; x1[1] = last ? nA1[1] : cA1[1];
            PG8_LDB(B0, 0, 0); PG8_LDB(B1, 0, 1); PG8_SCHED; PG8_LDA(At, 0, 0); PG8_STAGE(PG8_SA(1, 1), a1, cA1);
            PG8_WAIT_V(8); PG8_WAIT_L(0); PG8_BAR; PG8_MMA(0, 0, At, B0); PG8_MMA(0, 1, At, B1); PG8_BAR; PG8_SCHED;
            PG8_LDA(At, 0, 1); PG8_STAGE(PG8_SB(0, 0), b2, voffB); PG8_STAGE(PG8_SB(0, 1), b2 + hstep, voffB); PG8_STAGE(PG8_SA(0, 0), a2, x0);
            PG8_WAIT_V(8); PG8_WAIT_L(0); PG8_BAR; PG8_MMA(1, 0, At, B0); PG8_MMA(1, 1, At, B1); PG8_BAR; PG8_SCHED;
            PG8_LDB(B0, 1, 0); PG8_LDB(B1, 1, 1); PG8_SCHED; PG8_LDA(At, 1, 0); PG8_STAGE(PG8_SA(0, 1), a2, x1);
            PG8_WAIT_V(8); PG8_WAIT_L(0); PG8_BAR; PG8_MMA(0, 0, At, B0); PG8_MMA(0, 1, At, B1); PG8_BAR; PG8_SCHED;
            PG8_LDA(At, 1, 1); PG8_STAGE(PG8_SB(1, 0), b3, voffB); PG8_STAGE(PG8_SB(1, 1), b3 + hstep, voffB); PG8_STAGE(PG8_SA(1, 0), a3, x0);
            PG8_WAIT_V(8); PG8_WAIT_L(0); PG8_BAR; PG8_MMA(1, 0, At, B0); PG8_MMA(1, 1, At, B1); PG8_BAR; PG8_SCHED;
        }
        if constexpr (ALIGN_EPI) { if (wr == 0) PG8_BAR; }
        if constexpr (FP8) asm volatile("s_nop 15\n\ts_nop 15" ::: "memory");
        E(acc, cur, wr, wc, fr, fq);
        if (!has_next) break;
#pragma unroll
        for (int a = 0; a < 2; ++a)
#pragma unroll
            for (int b = 0; b < 2; ++b)
#pragma unroll
                for (int m = 0; m < 4; ++m)
#pragma unroll
                    for (int n = 0; n < 2; ++n) acc[a][b][m][n] = (f32x4){0.f, 0.f, 0.f, 0.f};
        cur = nxt; cB = nB; cA0[0] = nA0[0]; cA0[1] = nA0[1]; cA1[0] = nA1[0]; cA1[1] = nA1[1]; ++ui;
        if constexpr (ALIGN_EPI) { if (wr == 1) PG8_BAR; }
    }
    PG8_WAIT_V(0);
    if constexpr (!ALIGN_EPI) { if (wr == 0) PG8_BAR; }
    PG8_BAR;
#undef PG8_SA
#undef PG8_SB
#undef PG8_STAGE
#undef PG8_LDA
#undef PG8_LDB
#undef PG8_LD8
#undef PG8_HALF
#undef PG8_MMA
#undef PG8_WAIT_V
#undef PG8_WAIT_L
#undef PG8_BAR
#undef PG8_SCHED
}

struct DenseOrder {
    int nM, nN, nwg, G, c; const char* Bt; size_t tstep;
    __device__ void init(int nM_, int nN_, int G_, int c_, const void* Bt_, int KB) { nM = nM_; nN = nN_; nwg = nM * nN; G = G_; c = c_; Bt = (const char*)Bt_; tstep = (size_t)256 * KB; }
    __device__ __forceinline__ bool next(int i, Unit& u) const {
        const long L = (long)i * G + c; if (L >= nwg) return false;
        int wgid = (int)L; { const int q = nwg / 8, r = nwg % 8, xcd = wgid % 8, off = wgid / 8; wgid = (xcd < r ? xcd * (q + 1) : r * (q + 1) + (xcd - r) * q) + off; }
        const int nig = 8 * nN, gid = wgid / nig, fm = gid * 8, gsz = (nM - fm) < 8 ? (nM - fm) : 8;
        u.pm = fm + ((wgid % nig) % gsz); u.pn = (wgid % nig) / gsz; u.B = Bt + (size_t)u.pn * tstep; u.e = 0; u.mt = 0; u.nval = 256; u.slot0 = u.pm * 256; return true;
    }
};
struct DenseA {
    int KB;
    __device__ __forceinline__ void offs(const Unit& u, const int (&RA)[2], const int (&CA)[2], unsigned (&o0)[2], unsigned (&o1)[2]) const {
#pragma unroll
        for (int i = 0; i < 2; ++i) { o0[i] = (unsigned)((u.pm * 256 + RA[i]) * KB + CA[i] * 2); o1[i] = (unsigned)((u.pm * 256 + 128 + RA[i]) * KB + CA[i] * 2); }
    }
};
struct MoeOrder {
    const LAS int* tp; const LAS int* cb; int NPN, G, c; const char* W; size_t estride, tstep;
    __device__ __forceinline__ bool next(int i, Unit& u) const {
#define RFL(x) __builtin_amdgcn_readfirstlane(x)
        const int L = i * G + c; const int total = RFL(tp[NE]) * NPN; if (L >= total) return false;
        int e = 0;
        while (e < NE - 1 && RFL(tp[e + 1]) * NPN <= L) ++e;
        const int tpe = RFL(tp[e]), tpe1 = RFL(tp[e + 1]), cbe = RFL(cb[e]), cbe1 = RFL(cb[e + 1]);
        const int loc = L - tpe * NPN, tl = tpe1 - tpe;
        u.e = e; u.mt = loc % tl; u.pn = loc / tl; u.pm = 0; const int cnt = cbe1 - cbe;
        const int rem = cnt - u.mt * 256; u.nval = rem < 256 ? rem : 256; u.slot0 = cbe + u.mt * 256;
        u.B = W + (size_t)e * estride + (size_t)u.pn * tstep; return true;
#undef RFL
    }
};
struct GatherA {
    const int* list; int KB;
    __device__ __forceinline__ void offs(const Unit& u, const int (&RA)[2], const int (&CA)[2], unsigned (&o0)[2], unsigned (&o1)[2]) const {
#pragma unroll
        for (int i = 0; i < 2; ++i) {
            const int r0 = RA[i], r1 = 128 + RA[i];
            const int t0 = r0 < u.nval ? list[u.e * TOK2 + u.mt * 256 + r0] : 0, t1 = r1 < u.nval ? list[u.e * TOK2 + u.mt * 256 + r1] : 0;
            o0[i] = (unsigned)(t0 * KB + CA[i] * 2); o1[i] = (unsigned)(t1 * KB + CA[i] * 2); }
    }
};
struct SlotA {
    int KB;
    __device__ __forceinline__ void offs(const Unit& u, const int (&RA)[2], const int (&CA)[2], unsigned (&o0)[2], unsigned (&o1)[2]) const {
#pragma unroll
        for (int i = 0; i < 2; ++i) { o0[i] = (unsigned)((u.slot0 + RA[i]) * KB + CA[i] * 2); o1[i] = (unsigned)((u.slot0 + 128 + RA[i]) * KB + CA[i] * 2); }
    }
};

struct EpiBf16 {
    static constexpr bool PERM = true;
    bf16_t* O; int ldc;
    __device__ __forceinline__ void operator()(const f32x4 (&acc)[2][2][4][2], const Unit& u, int wr, int wc, int fr, int fq) const {
        const int row0 = u.pm * BM + wr * 64 + fr, col0 = u.pn * BM + wc * 32 + 8 * fq;
#pragma unroll
        for (int ai = 0; ai < 2; ++ai)
#pragma unroll
            for (int m = 0; m < 4; ++m) { bf16_t* rowp = O + (size_t)(row0 + ai * HALF + m * 16) * ldc + col0;
#pragma unroll
                for (int bj = 0; bj < 2; ++bj) { const f32x4 v0 = acc[ai][bj][m][0], v1 = acc[ai][bj][m][1];
                    u32x4 w; w.x = pk2(v0[0], v0[1]); w.y = pk2(v0[2], v0[3]); w.z = pk2(v1[0], v1[1]); w.w = pk2(v1[2], v1[3]);
                    *(u32x4*)(rowp + bj * HALF) = w; } }
    }
};
template <bool ADD> struct EpiGate {
    static constexpr bool PERM = true;
    bf16_t* MG; const bf16_t* P; int gcol;
    __device__ __forceinline__ void operator()(const f32x4 (&acc)[2][2][4][2], const Unit& u, int wr, int wc, int fr, int fq) const {
        const int row0 = u.pm * BM + wr * 64 + fr, col0 = u.pn * BM + wc * 32 + 8 * fq;
#pragma unroll
        for (int ai = 0; ai < 2; ++ai)
#pragma unroll
            for (int m = 0; m < 4; ++m) { const size_t row = (size_t)(row0 + ai * HALF + m * 16); const size_t prow = row + (size_t)NMETA * ((row >> 12) + 1);
#pragma unroll
                for (int bj = 0; bj < 2; ++bj) { const int col = col0 + bj * HALF;
                    const u32x4 g = *(const u32x4*)(P + prow * DINP + gcol + col);
                    f32x4 v0 = acc[ai][bj][m][0], v1 = acc[ai][bj][m][1];
                    v0[0] *= sigmoidf_(bflo(g.x)); v0[1] *= sigmoidf_(bfhi(g.x)); v0[2] *= sigmoidf_(bflo(g.y)); v0[3] *= sigmoidf_(bfhi(g.y));
                    v1[0] *= sigmoidf_(bflo(g.z)); v1[1] *= sigmoidf_(bfhi(g.z)); v1[2] *= sigmoidf_(bflo(g.w)); v1[3] *= sigmoidf_(bfhi(g.w));
                    bf16_t* op = MG + row * DM + col;
                    if (ADD) { const u32x4 o = *(const u32x4*)op;
                        v0[0] += bflo(o.x); v0[1] += bfhi(o.x); v0[2] += bflo(o.y); v0[3] += bfhi(o.y); v1[0] += bflo(o.z); v1[1] += bfhi(o.z); v1[2] += bflo(o.w); v1[3] += bfhi(o.w); }
                    u32x4 w; w.x = pk2(v0[0], v0[1]); w.y = pk2(v0[2], v0[3]); w.z = pk2(v1[0], v1[1]); w.w = pk2(v1[2], v1[3]);
                    *(u32x4*)op = w; } }
    }
};
struct EpiResid {
    static constexpr bool PERM = false;
    const float* x; float* out;
    __device__ __forceinline__ void operator()(const f32x4 (&acc)[2][2][4][2], const Unit& u, int wr, int wc, int fr, int fq) const {
        const int row0 = u.pm * BM + wr * 64 + fr, col0 = u.pn * BM + wc * 32 + 4 * fq;
#pragma unroll
        for (int ai = 0; ai < 2; ++ai)
#pragma unroll
            for (int m = 0; m < 4; ++m) { const size_t off = (size_t)(row0 + ai * HALF + m * 16) * DM + col0;
#pragma unroll
                for (int bj = 0; bj < 2; ++bj)
#pragma unroll
                    for (int n = 0; n < 2; ++n) { const f32x4 hv = *(const f32x4*)(x + off + bj * HALF + n * 16); *(f32x4*)(out + off + bj * HALF + n * 16) = acc[ai][bj][m][n] + hv; } }
    }
};
__device__ __forceinline__ unsigned pk4_fp8(float a, float b, float c, float d) { int w = 0; w = __builtin_amdgcn_cvt_pk_fp8_f32(a, b, w, false); w = __builtin_amdgcn_cvt_pk_fp8_f32(c, d, w, true); return (unsigned)w; }
struct EpiSwiglu {
    static constexpr bool PERM = true;
    unsigned char* HID; const float* bg; const float* bu;
    __device__ __forceinline__ void operator()(const f32x4 (&acc)[2][2][4][2], const Unit& u, int wr, int wc, int fr, int fq) const {
        const int f0 = u.pn * 128 + wc * 32 + 8 * fq; const float dq = 1.0f / (SC_X * SC_W);
        const f32x4 g0 = *(const f32x4*)(bg + u.e * DFF + f0), g1 = *(const f32x4*)(bg + u.e * DFF + f0 + 4), u0 = *(const f32x4*)(bu + u.e * DFF + f0), u1 = *(const f32x4*)(bu + u.e * DFF + f0 + 4);
#pragma unroll
        for (int ai = 0; ai < 2; ++ai)
#pragma unroll
            for (int m = 0; m < 4; ++m) { const int r = ai * HALF + wr * 64 + m * 16 + fr;
                if (r < u.nval) {
                    float hv[8];
#pragma unroll
                    for (int n = 0; n < 2; ++n) { const f32x4 gg = acc[ai][0][m][n] * dq + (n ? g1 : g0), uu = acc[ai][1][m][n] * dq + (n ? u1 : u0);
#pragma unroll
                        for (int j = 0; j < 4; ++j) { const float gt = fminf(gg[j], 7.0f), up = fminf(fmaxf(uu[j], -7.0f), 7.0f);
                            hv[4 * n + j] = SC_H * (up + 1.0f) * gt * __builtin_amdgcn_rcpf(1.0f + __builtin_amdgcn_exp2f(-1.702f * LOG2E * gt)); } }
                    *(u32x2*)(HID + (size_t)(u.slot0 + r) * DFF + f0) = (u32x2){pk4_fp8(hv[0], hv[1], hv[2], hv[3]), pk4_fp8(hv[4], hv[5], hv[6], hv[7])}; } }
    }
};
struct EpiDown {
    static constexpr bool PERM = true;
    bf16_t* Y; const float* bd; const float* glist;
    __device__ __forceinline__ void operator()(const f32x4 (&acc)[2][2][4][2], const Unit& u, int wr, int wc, int fr, int fq) const {
        const int col0 = u.pn * BM + wc * 32 + 8 * fq; const float dq = 1.0f / (SC_H * SC_W);
        f32x4 bv[2][2];
#pragma unroll
        for (int bj = 0; bj < 2; ++bj)
#pragma unroll
            for (int n = 0; n < 2; ++n) bv[bj][n] = *(const f32x4*)(bd + u.e * DM + col0 + bj * HALF + 4 * n);
#pragma unroll
        for (int ai = 0; ai < 2; ++ai)
#pragma unroll
            for (int m = 0; m < 4; ++m) { const int r = ai * HALF + wr * 64 + m * 16 + fr;
                if (r < u.nval) { const float gw = glist[u.e * TOK2 + u.mt * 256 + r];
#pragma unroll
                    for (int bj = 0; bj < 2; ++bj) { const f32x4 v0 = (acc[ai][bj][m][0] * dq + bv[bj][0]) * gw, v1 = (acc[ai][bj][m][1] * dq + bv[bj][1]) * gw;
                        u32x4 w; w.x = pk2(v0[0], v0[1]); w.y = pk2(v0[2], v0[3]); w.z = pk2(v1[0], v1[1]); w.w = pk2(v1[2], v1[3]);
                        *(u32x4*)(Y + (size_t)(u.slot0 + r) * DM + col0 + bj * HALF) = w; } } }
    }
};
}

struct Args { const float* in[19]; float* out; unsigned char* ws; int ph_lo, ph_hi; };
struct Frame {
    LAS unsigned char* lds; gu32* ctl; int tid, lane, wave, G, vcu;
};
#define MFMA32(a, b, c) __builtin_amdgcn_mfma_f32_32x32x16_bf16((a), (b), (c), 0, 0, 0)
__device__ __forceinline__ int crow(int reg, int h) { return (reg & 3) + 8 * (reg >> 2) + 4 * h; }

__device__ __forceinline__ void tr_load(float (&v)[32], const float* W, int N, int k0, int n0, int lane) {
    const int nn = n0 + (lane & 31); const bool ok = nn < N;
#pragma unroll
    for (int i = 0; i < 32; ++i) { const int kk = 2 * i + (lane >> 5); v[i] = ok ? __builtin_nontemporal_load(W + (size_t)(k0 + kk) * N + nn) : 0.f; }
}
template <bool F8> __device__ __forceinline__ void tr_finish(const float (&v)[32], int K, int N, void* WTv, int dst_row0, int k0, int n0, LAS float* scr, int lane) {
#pragma unroll
    for (int i = 0; i < 32; ++i) { const int kk = 2 * i + (lane >> 5); scr[kk * 33 + (lane & 31)] = v[i]; }
    LDS_WAIT(); asm volatile("" ::: "memory");
    if constexpr (F8) {
        unsigned char* WT = (unsigned char*)WTv; const int c = lane & 3;
#pragma unroll
        for (int j = 0; j < 2; ++j) { const int n = (lane >> 2) + 16 * j; const LAS float* s = scr + (16 * c) * 33 + n;
            u32x4 o; o.x = pg8::pk4_fp8(s[0 * 33] * SC_W, s[1 * 33] * SC_W, s[2 * 33] * SC_W, s[3 * 33] * SC_W); o.y = pg8::pk4_fp8(s[4 * 33] * SC_W, s[5 * 33] * SC_W, s[6 * 33] * SC_W, s[7 * 33] * SC_W);
            o.z = pg8::pk4_fp8(s[8 * 33] * SC_W, s[9 * 33] * SC_W, s[10 * 33] * SC_W, s[11 * 33] * SC_W); o.w = pg8::pk4_fp8(s[12 * 33] * SC_W, s[13 * 33] * SC_W, s[14 * 33] * SC_W, s[15 * 33] * SC_W);
            if (n0 + n < N) *(u32x4*)(WT + (size_t)(dst_row0 + n) * K + k0 + 16 * c) = o; }
    } else {
        bf16_t* WT = (bf16_t*)WTv; const int c = lane & 7;
#pragma unroll
        for (int j = 0; j < 4; ++j) { const int n = (lane >> 3) + 8 * j; const LAS float* s = scr + (8 * c) * 33 + n;
            u32x4 o; o.x = pk2(s[0 * 33], s[1 * 33]); o.y = pk2(s[2 * 33], s[3 * 33]); o.z = pk2(s[4 * 33], s[5 * 33]); o.w = pk2(s[6 * 33], s[7 * 33]);
            if (n0 + n < N) *(u32x4*)(WT + (size_t)(dst_row0 + n) * K + k0 + 8 * c) = o; }
    }
    LDS_WAIT(); asm volatile("" ::: "memory");
}
template <bool F8> __device__ __forceinline__ void p0_transpose_item(const float* W, int K, int N, void* WTv, int dst_row0, int k0, int n0, LAS float* scr, int lane) {
    float v[32]; tr_load(v, W, N, k0, n0, lane); tr_finish<F8>(v, K, N, WTv, dst_row0, k0, n0, scr, lane);
}
struct ExpItem { const float* W; unsigned char* WT; int dst_row0, k0, n0; };
__device__ __forceinline__ ExpItem exp_item(const Args& a, int r) {
    const int e = r / (3 * 2048), rr = r % (3 * 2048), mat = rr / 2048, q = rr % 2048, kb = q / 64, nb = q % 64, n0 = nb * 32;
    ExpItem it; it.k0 = kb * 64; it.n0 = n0;
    if (mat == 0) { it.W = a.in[12] + (size_t)e * DM * DFF; it.WT = a.ws + WS_WGU + (size_t)e * 4096 * DM; it.dst_row0 = (n0 >> 7) * 256 + (n0 & 127); }
    else if (mat == 1) { it.W = a.in[14] + (size_t)e * DM * DFF; it.WT = a.ws + WS_WGU + (size_t)e * 4096 * DM; it.dst_row0 = (n0 >> 7) * 256 + 128 + (n0 & 127); }
    else { it.W = a.in[16] + (size_t)e * DFF * DM; it.WT = a.ws + WS_WD + (size_t)e * DM * DFF; it.dst_row0 = n0; }
    return it;
}
constexpr int NCONV = NE * 3 * 2048 / 64;
__device__ __forceinline__ void conv_chunk(const Frame& F, const Args& a, int ci) {
    LAS float* scr = (LAS float*)(F.lds + F.wave * 16384);
    const int r0 = ci * 64 + F.wave * 8;
    float va[32], vb[32];
    ExpItem ia = exp_item(a, r0), ib;
    tr_load(va, ia.W, DFF, ia.k0, ia.n0, F.lane);
#pragma unroll
    for (int j = 0; j < 8; j += 2) {
        ib = exp_item(a, r0 + j + 1); tr_load(vb, ib.W, DFF, ib.k0, ib.n0, F.lane);
        tr_finish<true>(va, DM, DFF, ia.WT, ia.dst_row0, ia.k0, ia.n0, scr, F.lane);
        if (j + 2 < 8) { ia = exp_item(a, r0 + j + 2); tr_load(va, ia.W, DFF, ia.k0, ia.n0, F.lane); }
        tr_finish<true>(vb, DM, DFF, ib.WT, ib.dst_row0, ib.k0, ib.n0, scr, F.lane);
    }
}
__device__ __forceinline__ void p0_prologue(const Frame& F, const Args& a) {
    unsigned char* ws = a.ws;
    LAS float* scr = (LAS float*)(F.lds + F.wave * 16384);
    const int gw = F.vcu * NWAVES + F.wave, NGW = F.G * NWAVES, lane = F.lane;
    {
        const float* x = a.in[0]; const float* meta = a.in[1]; const float* g = a.in[2]; bf16_t* XN = (bf16_t*)(ws + WS_XN);
        f32x4 gv[8];
#pragma unroll
        for (int j = 0; j < 8; ++j) gv[j] = ((const f32x4*)g)[lane + 64 * j];
        for (int r = gw; r < MPAD; r += NGW) {
            unsigned long long* o8 = (unsigned long long*)(XN + (size_t)r * DM) + lane;
            if (r >= TROWS) {
#pragma unroll
                for (int j = 0; j < 8; ++j) o8[64 * j] = 0ull;
                continue; }
            const int b = r / LL, l = r - b * LL;
            const f32x4* src = (const f32x4*)(l < NMETA ? meta + (size_t)l * DM : x + (size_t)(b * SEQ + l - NMETA) * DM) + lane;
            f32x4 v[8]; float s = 0.f;
#pragma unroll
            for (int j = 0; j < 8; ++j) { v[j] = src[64 * j]; s += (v[j].x * v[j].x + v[j].y * v[j].y) + (v[j].z * v[j].z + v[j].w * v[j].w); }
            const float rstd = 1.0f / sqrtf(wave_sum(s) * (1.0f / DM) + EPS);
#pragma unroll
            for (int j = 0; j < 8; ++j) { const f32x4 y = v[j] * rstd * gv[j]; o8[64 * j] = (unsigned long long)pk2(y.x, y.y) | ((unsigned long long)pk2(y.z, y.w) << 32); }
        }
    }
    {
        float* rope = (float*)(ws + WS_ROPE);
        for (int it = gw * 64 + lane; it < LL * 8; it += NGW * 64) { const int pos = it >> 3, j = it & 7;
            const float fr = (float)pow(500000.0, -(double)j / 8.0); const float ang = (float)pos * fr;
            rope[pos * 16 + j] = (float)cos((double)ang); rope[pos * 16 + 8 + j] = (float)sin((double)ang); }
    }
    {
        const float* pw = a.in[4]; const float* ps = a.in[5]; const float* wbp = a.in[6]; bf16_t* WE = (bf16_t*)(ws + WS_WEFF);
        for (int it = gw; it < 4 * 64 * 32; it += NGW) { const int g = it >> 11, c4 = (it >> 5) & 63, nb = it & 31, n = nb * 64 + lane;
            float acc0 = 0.f, acc1 = 0.f, acc2 = 0.f, acc3 = 0.f; const float* pr = pw + (size_t)(g * 256 + c4 * 4) * 256;
            for (int d = 0; d < 256; ++d) { const float wv = wbp[(size_t)(g * 256 + d) * DM + n] * ps[g * 256 + d];
                acc0 += pr[d] * wv; acc1 += pr[256 + d] * wv; acc2 += pr[512 + d] * wv; acc3 += pr[768 + d] * wv; }
            *(u32x2*)(WE + (size_t)n * 1024 + g * 256 + c4 * 4) = (u32x2){pk2(acc0, acc1), pk2(acc2, acc3)}; }
    }
    {
        constexpr int I_IN = 32 * 291, I_BA = 16 * 64, I_OUT = 32 * 64;
        constexpr int NITEMS = I_IN + I_BA + I_OUT;
        for (int it = gw; it < NITEMS; it += NGW) {
            int r = it;
            if (r < I_IN) { const int kb = r / 291, nb = r % 291; p0_transpose_item<false>(a.in[3], DM, DIN, (bf16_t*)(ws + WS_WIN), nb * 32, kb * 64, nb * 32, scr, lane); continue; } r -= I_IN;
            if (r < I_BA) { const int kb = r / 64, nb = r % 64; p0_transpose_item<false>(a.in[7], 1024, DM, (bf16_t*)(ws + WS_WBA), nb * 32, kb * 64, nb * 32, scr, lane); continue; } r -= I_BA;
            { const int kb = r / 64, nb = r % 64; p0_transpose_item<false>(a.in[8], DM, DM, (bf16_t*)(ws + WS_WOUT), nb * 32, kb * 64, nb * 32, scr, lane); }
        }
    }
}

__device__ __forceinline__ void p2_elementwise(const Frame& F, const Args& a) {
    unsigned char* ws = a.ws; bf16_t* P = (bf16_t*)(ws + WS_P); bf16_t* POOL = (bf16_t*)(ws + WS_POOL); bf16_t* VT = (bf16_t*)(ws + WS_VT); const float* rope = (const float*)(ws + WS_ROPE); bf16_t* IKF = (bf16_t*)(ws + WS_IKF);
    const int tid = F.tid, lane = F.lane, wave = F.wave;
    for (int unit = F.vcu; unit < NB * 65; unit += F.G) {
        const int b = unit / 65, st = unit % 65, l0 = st * 64, nl = (LL - l0) < 64 ? (LL - l0) : 64;
        const size_t rowb = (size_t)b * LL;
        {
            const int w = 2 << (tid >> 7); float s0 = 0.f, s1 = 0.f;
            for (int i = (l0 - w > 0 ? l0 - w : 0); i < l0; ++i) { const unsigned v = *(const unsigned*)(P + (rowb + i) * DINP + C_U + 2 * tid); s0 += bflo(v); s1 += bfhi(v); }
            for (int l = l0; l < l0 + nl; ++l) {
                const unsigned v = *(const unsigned*)(P + (rowb + l) * DINP + C_U + 2 * tid); const float u0 = bflo(v), u1 = bfhi(v);
                s0 += u0; s1 += u1;
                if (l - w >= 0) { const unsigned o = *(const unsigned*)(P + (rowb + l - w) * DINP + C_U + 2 * tid); s0 -= bflo(o); s1 -= bfhi(o); }
                const float ic = 1.0f / (float)((l + 1) < w ? (l + 1) : w);
                if (l >= NMETA) *(unsigned*)(POOL + ((size_t)b * SEQ + l - NMETA) * 1024 + 2 * tid) = pk2(s0 * ic - u0, s1 * ic - u1);
            }
        }
        for (int it = tid; it < nl * 48; it += NTHR) {
            const int rl = it / 48, hs = it % 48, l = l0 + rl;
            const int col = hs < 16 ? C_Q + hs * 64 : (hs < 32 ? C_K + (hs - 16) * 64 : C_IQ + (hs - 32) * 64);
            bf16_t* p = P + (rowb + l) * DINP + col;
            const u32x4 x1 = *(const u32x4*)p, x2 = *(const u32x4*)(p + 8);
            const f32x4 c0 = *(const f32x4*)(rope + l * 16), c1 = *(const f32x4*)(rope + l * 16 + 4), s0 = *(const f32x4*)(rope + l * 16 + 8), s1 = *(const f32x4*)(rope + l * 16 + 12);
            const float a0 = bflo(x1.x), a1 = bfhi(x1.x), a2 = bflo(x1.y), a3 = bfhi(x1.y), a4 = bflo(x1.z), a5 = bfhi(x1.z), a6 = bflo(x1.w), a7 = bfhi(x1.w);
            const float b0 = bflo(x2.x), b1 = bfhi(x2.x), b2 = bflo(x2.y), b3 = bfhi(x2.y), b4 = bflo(x2.z), b5 = bfhi(x2.z), b6 = bflo(x2.w), b7 = bfhi(x2.w);
            u32x4 o1, o2;
            o1.x = pk2(a0 * c0.x - b0 * s0.x, a1 * c0.y - b1 * s0.y); o1.y = pk2(a2 * c0.z - b2 * s0.z, a3 * c0.w - b3 * s0.w);
            o1.z = pk2(a4 * c1.x - b4 * s1.x, a5 * c1.y - b5 * s1.y); o1.w = pk2(a6 * c1.z - b6 * s1.z, a7 * c1.w - b7 * s1.w);
            o2.x = pk2(b0 * c0.x + a0 * s0.x, b1 * c0.y + a1 * s0.y); o2.y = pk2(b2 * c0.z + a2 * s0.z, b3 * c0.w + a3 * s0.w);
            o2.z = pk2(b4 * c1.x + a4 * s1.x, b5 * c1.y + a5 * s1.y); o2.w = pk2(b6 * c1.z + a6 * s1.z, b7 * c1.w + a7 * s1.w);
            *(u32x4*)p = o1; *(u32x4*)(p + 8) = o2;
        }
        for (int it = tid; it < nl * 7; it += NTHR) {
            const int rl = it / 7, i7 = it % 7, l = l0 + rl, t = l >> 5, r5 = l & 31;
            const bf16_t* p = P + (rowb + l) * DINP + C_IK;
            bf16_t* dst = IKF + ((size_t)(b * NTK + t) * 4) * 512 + r5 * 8;
            if (i7 == 0) {
                const u32x4 x1 = *(const u32x4*)p, x2 = *(const u32x4*)(p + 8);
                const f32x4 c0 = *(const f32x4*)(rope + l * 16), c1 = *(const f32x4*)(rope + l * 16 + 4), s0 = *(const f32x4*)(rope + l * 16 + 8), s1 = *(const f32x4*)(rope + l * 16 + 12);
                const float a0 = bflo(x1.x), a1 = bfhi(x1.x), a2 = bflo(x1.y), a3 = bfhi(x1.y), a4 = bflo(x1.z), a5 = bfhi(x1.z), a6 = bflo(x1.w), a7 = bfhi(x1.w);
                const float b0 = bflo(x2.x), b1 = bfhi(x2.x), b2 = bflo(x2.y), b3 = bfhi(x2.y), b4 = bflo(x2.z), b5 = bfhi(x2.z), b6 = bflo(x2.w), b7 = bfhi(x2.w);
                u32x4 o1, o2;
                o1.x = pk2(a0 * c0.x - b0 * s0.x, a1 * c0.y - b1 * s0.y); o1.y = pk2(a2 * c0.z - b2 * s0.z, a3 * c0.w - b3 * s0.w);
                o1.z = pk2(a4 * c1.x - b4 * s1.x, a5 * c1.y - b5 * s1.y); o1.w = pk2(a6 * c1.z - b6 * s1.z, a7 * c1.w - b7 * s1.w);
                o2.x = pk2(b0 * c0.x + a0 * s0.x, b1 * c0.y + a1 * s0.y); o2.y = pk2(b2 * c0.z + a2 * s0.z, b3 * c0.w + a3 * s0.w);
                o2.z = pk2(b4 * c1.x + a4 * s1.x, b5 * c1.y + a5 * s1.y); o2.w = pk2(b6 * c1.z + a6 * s1.z, b7 * c1.w + a7 * s1.w);
                *(u32x4*)dst = o1; *(u32x4*)(dst + 256) = o2;
            } else { const int c = 1 + ((i7 - 1) >> 1), h2 = (i7 - 1) & 1;
                *(u32x4*)(dst + c * 512 + h2 * 256) = *(const u32x4*)(p + 16 * c + 8 * h2); }
        }
        for (int hh = 0; hh < 2; ++hh) {
            const int hd = 2 * wave + hh; const int l = l0 + lane;
            u32x4 v[8];
            if (l < LL) {
#pragma unroll
                for (int j = 0; j < 8; ++j) v[j] = *(const u32x4*)(P + (rowb + l) * DINP + C_V + hd * 64 + 8 * j);
            } else {
#pragma unroll
                for (int j = 0; j < 8; ++j) v[j] = (u32x4){0u, 0u, 0u, 0u};
            }
            bf16_t* dst = VT + (size_t)((b * NH + hd) * 64) * KPAD + l;
#pragma unroll
            for (int j = 0; j < 8; ++j) {
                dst[(size_t)(8 * j + 0) * KPAD] = (bf16_t)(v[j].x & 0xffffu); dst[(size_t)(8 * j + 1) * KPAD] = (bf16_t)(v[j].x >> 16);
                dst[(size_t)(8 * j + 2) * KPAD] = (bf16_t)(v[j].y & 0xffffu); dst[(size_t)(8 * j + 3) * KPAD] = (bf16_t)(v[j].y >> 16);
                dst[(size_t)(8 * j + 4) * KPAD] = (bf16_t)(v[j].z & 0xffffu); dst[(size_t)(8 * j + 5) * KPAD] = (bf16_t)(v[j].z >> 16);
                dst[(size_t)(8 * j + 6) * KPAD] = (bf16_t)(v[j].w & 0xffffu); dst[(size_t)(8 * j + 7) * KPAD] = (bf16_t)(v[j].w >> 16);
            }
        }
    }
}

constexpr int SC_PITCH = 4160;
__device__ __forceinline__ unsigned f2key(float f) { const unsigned u = __float_as_uint(f); return u ^ ((unsigned)((int)u >> 31) | 0x80000000u); }
template <int NR> __device__ __forceinline__ void select_row(const LAS float* scrow, const int n, const int lane, unsigned long long* mrow) {
    unsigned key[NR];
#pragma unroll
    for (int i = 0; i < NR; ++i) { const int k = 64 * i + lane; key[i] = k < n ? f2key(scrow[k]) : 0u; }
    unsigned Pfx = 0u; bool exact = false;
    for (int bit = 31; bit >= 0; --bit) {
        const unsigned cand = Pfx | (1u << bit); int c = 0;
#pragma unroll
        for (int i = 0; i + 4 <= NR; i += 4) {
            unsigned long long m0, m1, m2, m3;
            asm volatile("v_cmp_ge_u32_e64 %0, %4, %8\n\tv_cmp_ge_u32_e64 %1, %5, %8\n\tv_cmp_ge_u32_e64 %2, %6, %8\n\tv_cmp_ge_u32_e64 %3, %7, %8"
                         : "=&s"(m0), "=&s"(m1), "=&s"(m2), "=&s"(m3) : "v"(key[i]), "v"(key[i + 1]), "v"(key[i + 2]), "v"(key[i + 3]), "v"(cand));
            c += (__builtin_popcountll(m0) + __builtin_popcountll(m1)) + (__builtin_popcountll(m2) + __builtin_popcountll(m3));
        }
#pragma unroll
        for (int i = NR & ~3; i < NR; ++i) c += __builtin_popcountll(__ballot(key[i] >= cand));
        if (c >= NSEL) { Pfx = cand; if (c == NSEL) { exact = true; break; } }
    }
    unsigned long long myw = 0ull, myw2 = 0ull;
    if (exact) {
#pragma unroll
        for (int i = 0; i < NR; ++i) { const unsigned long long bl = __ballot(key[i] >= Pfx); if (i < 64) { if (lane == i) myw = bl; } else { if (lane == 0) myw2 = bl; } }
    } else {
        int g = 0;
#pragma unroll
        for (int i = 0; i < NR; ++i) g += __builtin_popcountll(__ballot(key[i] > Pfx));
        const int need = NSEL - g; int run = 0;
#pragma unroll
        for (int i = 0; i < NR; ++i) { const bool eq = key[i] == Pfx; const unsigned long long be = __ballot(eq);
            const int rank = run + __builtin_amdgcn_mbcnt_hi((unsigned)(be >> 32), __builtin_amdgcn_mbcnt_lo((unsigned)be, 0u));
            const bool sel = (key[i] > Pfx) || (eq && rank < need);
            const unsigned long long bl = __ballot(sel); run += __builtin_popcountll(be);
            if (i < 64) { if (lane == i) myw = bl; } else { if (lane == 0) myw2 = bl; } }
    }
    mrow[(size_t)lane * KPAD] = myw;
    if (lane == 0) mrow[(size_t)64 * KPAD] = myw2;
    if (lane == 1) mrow[(size_t)65 * KPAD] = 0ull;
}
__device__ __forceinline__ void p3_select(const Frame& F, const Args& a, const int tw) {
    (void)tw;
    unsigned char* ws = a.ws; const bf16_t* P = (const bf16_t*)(ws + WS_P); unsigned long long* MASK = (unsigned long long*)(ws + WS_MASK);
    LAS float* sc = (LAS float*)F.lds;
    LAS unsigned char* stg = F.lds + IKST_OFF;
    const unsigned stgb = (unsigned)(size_t)stg;
    const int lane = F.lane, wave = F.wave, r32 = lane & 31, hh = lane >> 5;
    constexpr int NUN = NB * 512;
    const int G2 = 2 * F.G, cid = (int)blockIdx.x;
    const bool xcdmap = (F.G % 8 == 0) && (512 % (F.G / 4) == 0); const int R = F.G / 8, rnk = cid / 8;
#define P3_UNIT(K) (xcdmap ? ((((K) & 1) ? ((K) >> 1) * 2 * R + 2 * R - 1 - rnk : ((K) >> 1) * 2 * R + rnk) < 512 ? (((K) & 1) ? ((K) >> 1) * 2 * R + 2 * R - 1 - rnk : ((K) >> 1) * 2 * R + rnk) * NB + (cid & 7) : NUN) \
                          : (((K) & 1) ? ((K) >> 1) * G2 + G2 - 1 - cid : ((K) >> 1) * G2 + cid))
    int k = 0, u = P3_UNIT(0);
#define P3_DMA(U) do { const int grp_ = 513 - (U) / NB, b_ = (U) % NB, l0_ = grp_ * 8; \
        if (l0_ >= NSEL) { const bf16_t* qrow_ = P + ((size_t)b_ * LL + l0_ + wave) * DINP + C_IQ; \
            pg8::glds16_sv(qrow_, (unsigned)lane * 16u, (unsigned)__builtin_amdgcn_readfirstlane((int)(stgb + (unsigned)wave * 2048u))); \
            pg8::glds16_sv(qrow_ + 512, (unsigned)lane * 16u, (unsigned)__builtin_amdgcn_readfirstlane((int)(stgb + (unsigned)wave * 2048u + 1024u))); \
            if (wave == 0 && lane < 16) pg8::glds16_sv(P + ((size_t)b_ * LL + l0_) * DINP + C_IW, (unsigned)((lane >> 1) * (DINP * 2) + (lane & 1) * 16), stgb + 16384u); } } while (0)
    if (u < NUN) P3_DMA(u);
    asm volatile("s_waitcnt vmcnt(0)" ::: "memory");
    __syncthreads();
    while (u < NUN) {
        const int grp = 513 - u / NB, b = u % NB, l0 = grp * 8;
        const size_t rowb = (size_t)b * LL;
        const int q = l0 + wave;
        ++k; const int un = P3_UNIT(k);
        if (l0 >= NSEL) {
            const int ntl = (l0 + 8 + 31) >> 5;
            const int ph = wave & 1, tq = wave >> 1;
            const bf16_t* kcol = (const bf16_t*)(ws + WS_IKF) + (size_t)(b * NTK) * 2048 + lane * 8;
            bf16x8 br[4][4];
#pragma unroll
            for (int j = 0; j < 4; ++j) { const int tj = (tq + 4 * j) < ntl ? tq + 4 * j : tq;
#pragma unroll
                for (int c = 0; c < 4; ++c) br[j][c] = *(const bf16x8*)(kcol + (size_t)(4 * tj + c) * 512); }
            bf16x8 af[2][4]; float sg[2][16];
#pragma unroll
            for (int p2 = 0; p2 < 2; ++p2) {
                const int pr = 2 * ph + p2;
                const int qq = 2 * pr + ((r32 >> 2) & 1), head = (r32 >> 3) * 4 + (r32 & 3);
                const float wsc = fabsf(bf2f(*(const LAS unsigned short*)(stg + 16384 + qq * 32 + head * 2))) * 0.03125f;
#pragma unroll
                for (int c = 0; c < 4; ++c) { const u32x4 v = *(const LAS u32x4*)(stg + qq * 2048 + (head * 64 + 16 * c + 8 * hh) * 2); u32x4 o;
                    o.x = pk2(bflo(v.x) * wsc, bfhi(v.x) * wsc); o.y = pk2(bflo(v.y) * wsc, bfhi(v.y) * wsc); o.z = pk2(bflo(v.z) * wsc, bfhi(v.z) * wsc); o.w = pk2(bflo(v.w) * wsc, bfhi(v.w) * wsc);
                    af[p2][c] = __builtin_bit_cast(bf16x8, o); }
                const u32x4 w0 = *(const LAS u32x4*)(stg + 16384 + (2 * pr + hh) * 32), w1 = *(const LAS u32x4*)(stg + 16384 + (2 * pr + hh) * 32 + 16);
                const unsigned ww[8] = {w0.x, w0.y, w0.z, w0.w, w1.x, w1.y, w1.z, w1.w};
#pragma unroll
                for (int i = 0; i < 8; ++i) { sg[p2][2 * i] = bflo(ww[i]) < 0.f ? -1.f : 1.f; sg[p2][2 * i + 1] = bfhi(ww[i]) < 0.f ? -1.f : 1.f; }
            }
            __syncthreads();
            if (un < NUN) P3_DMA(un);
            for (int t0 = tq; t0 < ntl; t0 += 16) {
#pragma unroll
                for (int j = 0; j < 4; ++j) {
                    const int t = t0 + 4 * j;
                    if (t < ntl) {
#pragma unroll
                        for (int p2 = 0; p2 < 2; ++p2) {
                            f32x16 z = {};
#pragma unroll
                            for (int c = 0; c < 4; ++c) z = MFMA32(af[p2][c], br[j][c], z);
                            float s0 = 0.f, s1 = 0.f;
#pragma unroll
                            for (int i = 0; i < 16; i += 2) { s0 += sg[p2][i] * fmaxf(z[i], 0.f); s1 += sg[p2][i + 1] * fmaxf(z[i + 1], 0.f); }
                            sc[(2 * (2 * ph + p2) + hh) * SC_PITCH + 32 * t + r32] = s0 + s1;
                        }
                        if (t + 16 < ntl) {
#pragma unroll
                            for (int c = 0; c < 4; ++c) br[j][c] = *(const bf16x8*)(kcol + (size_t)(4 * (t + 16) + c) * 512); }
                    }
                }
            }
        } else {
            if (un < NUN) P3_DMA(un);
        }
        __syncthreads();
        unsigned long long* mrow = MASK + (size_t)b * MASKW * KPAD + q;
        if (l0 < NSEL) {
            for (int i = lane; i < MASKW; i += 64) { const int lo = 64 * i; unsigned long long wv = 0ull;
                if (lo + 63 <= q) wv = ~0ull; else if (lo <= q) wv = (~0ull) >> (63 - (q - lo));
                mrow[(size_t)i * KPAD] = wv; }
        } else {
            const int n = q + 1; const LAS float* scrow = sc + wave * SC_PITCH;
            const int nr = (n + 63) >> 6;
            if (nr <= 8) select_row<8>(scrow, n, lane, mrow);
            else if (nr <= 16) select_row<16>(scrow, n, lane, mrow);
            else if (nr <= 24) select_row<24>(scrow, n, lane, mrow);
            else if (nr <= 32) select_row<32>(scrow, n, lane, mrow);
            else if (nr <= 40) select_row<40>(scrow, n, lane, mrow);
            else if (nr <= 48) select_row<48>(scrow, n, lane, mrow);
            else if (nr <= 56) select_row<56>(scrow, n, lane, mrow);
            else select_row<65>(scrow, n, lane, mrow);
        }
        asm volatile("s_waitcnt vmcnt(0)" ::: "memory");
        __syncthreads();
        u = un;
    }
#undef P3_DMA
#undef P3_UNIT
}

constexpr int KV_PITCH = 72;
constexpr int KV_TILE = 64 * KV_PITCH * 2;
__device__ __forceinline__ void p4_attention(const Frame& F, const Args& a, const int tw) {
    unsigned char* ws = a.ws; const bf16_t* P = (const bf16_t*)(ws + WS_P); const bf16_t* VT = (const bf16_t*)(ws + WS_VT); bf16_t* O = (bf16_t*)(ws + WS_O);
    const unsigned long long* MASK = (const unsigned long long*)(ws + WS_MASK);
    LAS unsigned char* lds = F.lds; volatile LAS int* tick = (volatile LAS int*)(F.lds + LDSCTL_OFF + 64);
    const int tid = F.tid, lane = F.lane, wave = F.wave, r32 = lane & 31, hh = lane >> 5;
    const int srow = tid >> 3, sch = tid & 7;
    const float CS = 0.125f * LOG2E;
    for (;;) {
        __syncthreads();
        if (tid == 0) tick[0] = (int)__hip_atomic_fetch_add(F.ctl + CW_TICKET + 64 * tw, 1u, RLX_AGENT);
        __syncthreads();
        const int ti = tick[0];
        if (ti >= NB * NH * 16 + NCONV) break;
        const int tg = ti / 5, tr5 = ti % 5;
        if (tr5 < 3) { conv_chunk(F, a, tg * 3 + tr5); continue; }
        const int ui = tg * 2 + (tr5 - 3);
        const int jb = 15 - ui / (NB * NH), bh = ui % (NB * NH), b = bh / NH, hd = bh % NH;
        const int q_lo = NMETA + 256 * jb, q_hi = q_lo + 255, nt = q_hi / 64 + 1;
        const size_t rowb = (size_t)b * LL;
        const int q = q_lo + 32 * wave + r32;
        const int qmax_w = q_lo + 32 * wave + 31;
        bf16x8 qf[4];
#pragma unroll
        for (int c = 0; c < 4; ++c) qf[c] = *(const bf16x8*)(P + (rowb + q) * DINP + C_Q + hd * 64 + 16 * c + 8 * hh);
        const unsigned long long* mq = MASK + (size_t)b * MASKW * KPAD + q;
        const bf16_t* kbase = P + rowb * DINP + C_K + hd * 64 + sch * 8;
        const bf16_t* vbase = VT + (size_t)((b * NH + hd) * 64 + srow) * KPAD + sch * 8;
        f32x16 o0 = {}, o1 = {}; float m = -1e30f, lsum = 0.f;
        u32x4 kA, vA, kB = {}, vB = {}; unsigned long long mw0, mw1 = 0ull, mw2 = 0ull;
        { const u32x4 k0r = *(const u32x4*)(kbase + (size_t)srow * DINP), v0r = *(const u32x4*)(vbase);
          kA = *(const u32x4*)(kbase + (size_t)(64 + srow) * DINP); vA = *(const u32x4*)(vbase + 64);
          mw0 = mq[0]; mw1 = mq[KPAD];
          *(LAS u32x4*)(lds + srow * (KV_PITCH * 2) + sch * 16) = k0r; *(LAS u32x4*)(lds + KV_TILE + srow * (KV_PITCH * 2) + sch * 16) = v0r; }
        __syncthreads();
#define ATT_STEP(KT, KX, VX, KY, VY) do { const int kt = (KT); \
            const int buf = kt & 1; LAS unsigned char* Kl = lds + buf * 2 * KV_TILE; LAS unsigned char* Vl = Kl + KV_TILE; \
            if (kt + 2 < nt) { KY = *(const u32x4*)(kbase + (size_t)(64 * (kt + 2) + srow) * DINP); VY = *(const u32x4*)(vbase + 64 * (kt + 2)); mw2 = mq[(size_t)(kt + 2) * KPAD]; } \
            if (64 * kt <= qmax_w) { \
                f32x16 p0 = {}, p1 = {}; \
                _Pragma("unroll") for (int c = 0; c < 4; ++c) { \
                    const bf16x8 k0 = *(const LAS bf16x8*)(Kl + r32 * (KV_PITCH * 2) + (16 * c + 8 * hh) * 2); \
                    const bf16x8 k1 = *(const LAS bf16x8*)(Kl + (32 + r32) * (KV_PITCH * 2) + (16 * c + 8 * hh) * 2); \
                    p0 = MFMA32(k0, qf[c], p0); p1 = MFMA32(k1, qf[c], p1); } \
                float mx = fmaxf(p0[0], p1[0]); \
                _Pragma("unroll") for (int i = 1; i < 16; ++i) mx = fmaxf(mx, fmaxf(p0[i], p1[i])); \
                mx = fmaxf(mx, __shfl_xor(mx, 32)) * CS; \
                if (__any(mx > m)) { const float mn = fmaxf(m, mx), alpha = __builtin_amdgcn_exp2f(m - mn); m = mn; lsum *= alpha; \
                    _Pragma("unroll") for (int i = 0; i < 16; ++i) { o0[i] *= alpha; o1[i] *= alpha; } } \
                const unsigned wlo = (unsigned)mw0 >> (4 * hh), whi = (unsigned)(mw0 >> 32) >> (4 * hh); \
                float ps0 = 0.f, ps1 = 0.f; \
                _Pragma("unroll") for (int i = 0; i < 16; ++i) { const int bp = (i & 3) + 8 * (i >> 2); \
                    const unsigned e0 = __float_as_uint(__builtin_amdgcn_exp2f(p0[i] * CS - m)) & (unsigned)__builtin_amdgcn_sbfe(wlo, bp, 1); \
                    const unsigned e1 = __float_as_uint(__builtin_amdgcn_exp2f(p1[i] * CS - m)) & (unsigned)__builtin_amdgcn_sbfe(whi, bp, 1); \
                    p0[i] = __uint_as_float(e0); p1[i] = __uint_as_float(e1); ps0 += p0[i]; ps1 += p1[i]; } \
                lsum += ps0 + ps1; \
                _Pragma("unroll") for (int blk = 0; blk < 2; ++blk) _Pragma("unroll") for (int s = 0; s < 2; ++s) { \
                        u32x4 pw; \
                        if (blk == 0) { pw.x = pk2(p0[8 * s], p0[8 * s + 1]); pw.y = pk2(p0[8 * s + 2], p0[8 * s + 3]); pw.z = pk2(p0[8 * s + 4], p0[8 * s + 5]); pw.w = pk2(p0[8 * s + 6], p0[8 * s + 7]); } \
                        else { pw.x = pk2(p1[8 * s], p1[8 * s + 1]); pw.y = pk2(p1[8 * s + 2], p1[8 * s + 3]); pw.z = pk2(p1[8 * s + 4], p1[8 * s + 5]); pw.w = pk2(p1[8 * s + 6], p1[8 * s + 7]); } \
                        const bf16x8 pf = __builtin_bit_cast(bf16x8, pw); \
                        const int kofs = (blk * 32 + 16 * s + 4 * hh) * 2; \
                        {   const s16x4 va = *(const LAS s16x4*)(Vl + r32 * (KV_PITCH * 2) + kofs), vb = *(const LAS s16x4*)(Vl + r32 * (KV_PITCH * 2) + kofs + 16); \
                            const bf16x8 vf = __builtin_shufflevector(va, vb, 0, 1, 2, 3, 4, 5, 6, 7); o0 = MFMA32(vf, pf, o0); } \
                        {   const s16x4 va = *(const LAS s16x4*)(Vl + (32 + r32) * (KV_PITCH * 2) + kofs), vb = *(const LAS s16x4*)(Vl + (32 + r32) * (KV_PITCH * 2) + kofs + 16); \
                            const bf16x8 vf = __builtin_shufflevector(va, vb, 0, 1, 2, 3, 4, 5, 6, 7); o1 = MFMA32(vf, pf, o1); } } \
            } \
            if (kt + 1 < nt) { LAS unsigned char* Kn = lds + (buf ^ 1) * 2 * KV_TILE; \
                *(LAS u32x4*)(Kn + srow * (KV_PITCH * 2) + sch * 16) = KX; *(LAS u32x4*)(Kn + KV_TILE + srow * (KV_PITCH * 2) + sch * 16) = VX; } \
            mw0 = mw1; mw1 = mw2; \
            __syncthreads(); } while (0)
        for (int kt2 = 0; kt2 < nt; kt2 += 2) {
            ATT_STEP(kt2, kA, vA, kB, vB);
            if (kt2 + 1 < nt) ATT_STEP(kt2 + 1, kB, vB, kA, vA);
        }
#undef ATT_STEP
        const float lt = lsum + __shfl_xor(lsum, 32); const float inv = 1.0f / lt;
        bf16_t* orow = O + ((size_t)b * SEQ + q - NMETA) * 1024 + hd * 64;
#pragma unroll
        for (int g = 0; g < 4; ++g) {
            *(u32x2*)(orow + 8 * g + 4 * hh) = (u32x2){pk2(o0[4 * g] * inv, o0[4 * g + 1] * inv), pk2(o0[4 * g + 2] * inv, o0[4 * g + 3] * inv)};
            *(u32x2*)(orow + 32 + 8 * g + 4 * hh) = (u32x2){pk2(o1[4 * g] * inv, o1[4 * g + 1] * inv), pk2(o1[4 * g + 2] * inv, o1[4 * g + 3] * inv)}; }
    }
}

__device__ __forceinline__ void p7_router(const Frame& F, const Args& a) {
    unsigned char* ws = a.ws; const float* H1 = a.out; unsigned char* XN2 = ws + WS_XN;
    const float* g2 = a.in[9]; const float* rw = a.in[10]; const float* rb = a.in[11];
    int* tok_e = (int*)(ws + WS_ROUTE + RT_TOKE); int* tok_p = (int*)(ws + WS_ROUTE + RT_TOKP); int* list = (int*)(ws + WS_ROUTE + RT_LIST); float* glist = (float*)(ws + WS_ROUTE + RT_GLIST);
    LAS float* xs = (LAS float*)F.lds;
    LAS float* wsm = xs + 128 * 68;
    LAS float* lg = wsm + 64 * 32;
    LAS float* rs = lg + 128 * 33;
    LAS int* hist = (LAS int*)(rs + 128);
    LAS int* gbase = hist + 32;
    const int tid = F.tid, lane = F.lane, wave = F.wave;
    for (int tile = F.vcu; tile < TOK2 / 128; tile += F.G) {
        const int t0 = tile * 128;
        const int tt = tid & 63, eg = tid >> 6;
        float acc[2][4] = {{0.f, 0.f, 0.f, 0.f}, {0.f, 0.f, 0.f, 0.f}}; float ssq0 = 0.f, ssq1 = 0.f;
        if (tid < 32) hist[tid] = 0;
        for (int kc = 0; kc < DM / 64; ++kc) {
            __syncthreads();
#pragma unroll
            for (int j = 0; j < 4; ++j) { const int idx = tid + 512 * j, row = idx >> 4, c4 = idx & 15;
                *(LAS f32x4*)(xs + row * 68 + c4 * 4) = *(const f32x4*)(H1 + (size_t)(t0 + row) * DM + kc * 64 + c4 * 4); }
            { const int d = tid >> 3, e4 = tid & 7; const f32x4 wv = *(const f32x4*)(rw + (size_t)(kc * 64 + d) * NE + e4 * 4); *(LAS f32x4*)(wsm + d * 32 + e4 * 4) = wv * g2[kc * 64 + d]; }
            __syncthreads();
#pragma unroll 4
            for (int k4 = 0; k4 < 16; ++k4) {
                const f32x4 xa = *(const LAS f32x4*)(xs + tt * 68 + 4 * k4), xb = *(const LAS f32x4*)(xs + (tt + 64) * 68 + 4 * k4);
#pragma unroll
                for (int kk = 0; kk < 4; ++kk) { const f32x4 wv = *(const LAS f32x4*)(wsm + (4 * k4 + kk) * 32 + 4 * eg);
#pragma unroll
                    for (int j = 0; j < 4; ++j) { acc[0][j] += xa[kk] * wv[j]; acc[1][j] += xb[kk] * wv[j]; }
                    ssq0 += xa[kk] * xa[kk]; ssq1 += xb[kk] * xb[kk]; }
            }
        }
        const float r0 = 1.0f / sqrtf(ssq0 * (1.0f / DM) + EPS), r1 = 1.0f / sqrtf(ssq1 * (1.0f / DM) + EPS);
#pragma unroll
        for (int j = 0; j < 4; ++j) { lg[tt * 33 + 4 * eg + j] = acc[0][j] * r0 + rb[4 * eg + j]; lg[(tt + 64) * 33 + 4 * eg + j] = acc[1][j] * r1 + rb[4 * eg + j]; }
        if (eg == 0) { rs[tt] = r0; rs[tt + 64] = r1; }
        __syncthreads();
        int te[4], tl[4]; float tg[4];
        if (tid < 128) {
            float v[32];
#pragma unroll
            for (int e = 0; e < 32; ++e) v[e] = lg[tid * 33 + e];
            float tv[4];
#pragma unroll
            for (int k = 0; k < 4; ++k) { float best = -INFINITY; int bi = 0;
#pragma unroll
                for (int e = 0; e < 32; ++e) { const bool tk = v[e] > best; best = tk ? v[e] : best; bi = tk ? e : bi; }
                tv[k] = best; te[k] = bi;
#pragma unroll
                for (int e = 0; e < 32; ++e) v[e] = (e == bi) ? -INFINITY : v[e]; }
            const float e1 = __expf(tv[1] - tv[0]), e2 = __expf(tv[2] - tv[0]), e3 = __expf(tv[3] - tv[0]); const float inv = 1.0f / (1.0f + e1 + e2 + e3);
            tg[0] = inv; tg[1] = e1 * inv; tg[2] = e2 * inv; tg[3] = e3 * inv;
#pragma unroll
            for (int k = 0; k < 4; ++k) tl[k] = atomicAdd((int*)&hist[te[k]], 1);
        }
        __syncthreads();
        if (tid < 32) gbase[tid] = (int)__hip_atomic_fetch_add(F.ctl + CW_CURSOR + tid, (unsigned)hist[tid], RLX_AGENT);
        __syncthreads();
        if (tid < 128) {
            const int t2 = t0 + tid;
#pragma unroll
            for (int k = 0; k < 4; ++k) { const int pos = gbase[te[k]] + tl[k]; list[te[k] * TOK2 + pos] = t2; glist[te[k] * TOK2 + pos] = tg[k]; tok_e[t2 * 4 + k] = te[k]; tok_p[t2 * 4 + k] = pos; }
        }
        f32x4 gv[8];
#pragma unroll
        for (int j = 0; j < 8; ++j) gv[j] = ((const f32x4*)g2)[lane + 64 * j];
        for (int rr = 0; rr < 16; ++rr) { const int row = wave * 16 + rr; const float rstd = rs[row];
            const f32x4* src = (const f32x4*)(H1 + (size_t)(t0 + row) * DM) + lane; unsigned* o4 = (unsigned*)(XN2 + (size_t)(t0 + row) * DM) + lane;
#pragma unroll
            for (int j = 0; j < 8; ++j) { const f32x4 y = src[64 * j] * (rstd * SC_X) * gv[j]; o4[64 * j] = pg8::pk4_fp8(y.x, y.y, y.z, y.w); } }
        __syncthreads();
    }
}

__device__ __forceinline__ void moe_tables(const Frame& F, LAS int* tp, LAS int* cb) {
    __syncthreads();
    if (F.tid == 0) { int t = 0, c = 0;
        for (int e = 0; e < NE; ++e) { tp[e] = t; cb[e] = c; const int n = (int)__hip_atomic_load(F.ctl + CW_CURSOR + e, RLX_AGENT); t += (n + 255) >> 8; c += n; }
        tp[NE] = t; cb[NE] = c; }
    __syncthreads();
}

__device__ __forceinline__ void p11_combine(const Frame& F, const Args& a, const LAS int* cb) {
    unsigned char* ws = a.ws; float* out = a.out; const bf16_t* Y = (const bf16_t*)(ws + WS_Y); const float* gf = a.in[18];
    const int* tok_e = (const int*)(ws + WS_ROUTE + RT_TOKE); const int* tok_p = (const int*)(ws + WS_ROUTE + RT_TOKP);
    const int gw = F.vcu * NWAVES + F.wave, NGW = F.G * NWAVES, lane = F.lane;
    f32x4 gv[8];
#pragma unroll
    for (int j = 0; j < 8; ++j) gv[j] = ((const f32x4*)gf)[lane + 64 * j];
    for (int t2 = gw; t2 < TOK2; t2 += NGW) {
        f32x4* row = (f32x4*)(out + (size_t)t2 * DM) + lane;
        f32x4 v[8];
#pragma unroll
        for (int j = 0; j < 8; ++j) v[j] = row[64 * j];
#pragma unroll
        for (int k = 0; k < 4; ++k) { const int e = tok_e[t2 * 4 + k], slot = cb[e] + tok_p[t2 * 4 + k];
            const u32x2* yr = (const u32x2*)(Y + (size_t)slot * DM) + lane;
#pragma unroll
            for (int j = 0; j < 8; ++j) { const u32x2 w = yr[64 * j]; v[j].x += bflo(w.x); v[j].y += bfhi(w.x); v[j].z += bflo(w.y); v[j].w += bfhi(w.y); } }
        float s = 0.f;
#pragma unroll
        for (int j = 0; j < 8; ++j) s += (v[j].x * v[j].x + v[j].y * v[j].y) + (v[j].z * v[j].z + v[j].w * v[j].w);
        const float rstd = 1.0f / sqrtf(wave_sum(s) * (1.0f / DM) + EPS);
#pragma unroll
        for (int j = 0; j < 8; ++j) row[64 * j] = v[j] * rstd * gv[j];
    }
}

constexpr int NPHASE = 11;
__global__ void __launch_bounds__(NTHR, 2) fwd_kernel(Args args) {
    extern __shared__ __attribute__((aligned(16))) unsigned char lds_raw[];
    Frame F;
    F.lds = (LAS unsigned char*)lds_raw;
    F.tid = threadIdx.x; F.lane = F.tid & 63; F.wave = __builtin_amdgcn_readfirstlane(F.tid >> 6);
    F.G = gridDim.x; { const int bx = blockIdx.x; F.vcu = (F.G % 8 == 0) ? (bx % 8) * (F.G / 8) + bx / 8 : bx; }
    unsigned char* ws = args.ws;
    F.ctl = (gu32*)(ws + WS_CTL);
    for (int u = F.tid; u < (LDS_BYTES - LDSCTL_OFF) / 4; u += NTHR) ((LAS unsigned*)(F.lds + LDSCTL_OFF))[u] = 0u;
    __syncthreads();
    volatile LAS unsigned* MISC = (volatile LAS unsigned*)(F.lds + LDSCTL_OFF);
    LAS int* tp = (LAS int*)(F.lds + LDSCTL_OFF + 256); LAS int* cb = tp + 40;
    const int lo = args.ph_lo, hi = args.ph_hi;
    const bool one = (hi - lo) > 1;
    XcdBarrier bar; bar.bar = (unsigned*)(F.ctl + CW_BAR); bar.x = 0; bar.st = nullptr;
    if (one) bar = xcd_barrier_post((unsigned*)(F.ctl + CW_BAR), MISC + 8);
#ifndef PH_MASK
#define PH_MASK 0x7ff
#endif
#define IN(k) ((((PH_MASK) >> (k)) & 1) && lo <= (k) && (k) < hi)
#define SEAM(k) do { if (IN(k) && IN((k) + 1)) xcd_barrier(bar); } while (0)
    const int G = F.G, cid = (int)blockIdx.x;

    if (IN(0)) { p0_prologue(F, args);
#if DBL == 0
        p0_prologue(F, args);
#endif
    } SEAM(0);

    if (IN(1)) {
        pg8::DenseOrder S; S.init(MPAD / 256, DINP / 256, G, cid, ws + WS_WIN, DM * 2); pg8::DenseA AM{DM * 2}; pg8::EpiBf16 E{(bf16_t*)(ws + WS_P), DINP};
        pg8::gemm_phase<pg8::EpiBf16, pg8::DenseOrder, pg8::DenseA, true, false>(F.lds, (const char*)(ws + WS_XN), DM * 2, S, AM, E);
#if DBL == 1
        pg8::gemm_phase<pg8::EpiBf16, pg8::DenseOrder, pg8::DenseA, true, false>(F.lds, (const char*)(ws + WS_XN), DM * 2, S, AM, E);
#endif
    } SEAM(1);

    if (IN(2)) { p2_elementwise(F, args); } SEAM(2);

    if (IN(3)) {
        pg8::DenseOrder S; S.init(TOK2 / 256, DM / 256, G, cid, ws + WS_WEFF, 2048); pg8::DenseA AM{2048}; pg8::EpiGate<false> E{(bf16_t*)(ws + WS_MG), (const bf16_t*)(ws + WS_P), C_GP};
        pg8::gemm_phase<pg8::EpiGate<false>, pg8::DenseOrder, pg8::DenseA, true, false>(F.lds, (const char*)(ws + WS_POOL), 2048, S, AM, E);
        p3_select(F, args, 0);
#if DBL == 3
        p3_select(F, args, 2);
#endif
    } SEAM(3);

    if (IN(4)) { p4_attention(F, args, 1);
#if DBL == 4
        p4_attention(F, args, 3);
#endif
    } SEAM(4);

    if (IN(5)) {
        pg8::DenseOrder S; S.init(TOK2 / 256, DM / 256, G, cid, ws + WS_WBA, 2048); pg8::DenseA AM{2048}; pg8::EpiGate<true> E{(bf16_t*)(ws + WS_MG), (const bf16_t*)(ws + WS_P), C_GA};
        pg8::gemm_phase<pg8::EpiGate<true>, pg8::DenseOrder, pg8::DenseA, true, false>(F.lds, (const char*)(ws + WS_O), 2048, S, AM, E);
    } SEAM(5);

    if (IN(6)) {
        pg8::DenseOrder S; S.init(TOK2 / 256, DM / 256, G, cid, ws + WS_WOUT, DM * 2); pg8::DenseA AM{DM * 2}; pg8::EpiResid E{args.in[0], args.out};
        pg8::gemm_phase<pg8::EpiResid, pg8::DenseOrder, pg8::DenseA, true, false>(F.lds, (const char*)(ws + WS_MG), DM * 2, S, AM, E);
    } SEAM(6);

    if (IN(7)) { p7_router(F, args); } SEAM(7);

    if (IN(8)) {
        moe_tables(F, tp, cb);
        pg8::MoeOrder S{tp, cb, 16, G, cid, (const char*)(ws + WS_WGU), (size_t)4096 * DM, (size_t)256 * DM};
        pg8::GatherA AM{(const int*)(ws + WS_ROUTE + RT_LIST), DM}; pg8::EpiSwiglu E{ws + WS_HID, args.in[13], args.in[15]};
        pg8::gemm_phase<pg8::EpiSwiglu, pg8::MoeOrder, pg8::GatherA, true, true>(F.lds, (const char*)(ws + WS_XN), DM, S, AM, E);
#if DBL == 89
        pg8::gemm_phase<pg8::EpiSwiglu, pg8::MoeOrder, pg8::GatherA, true, true>(F.lds, (const char*)(ws + WS_XN), DM, S, AM, E);
#endif
    } SEAM(8);

    if (IN(9)) {
        moe_tables(F, tp, cb);
        pg8::MoeOrder S{tp, cb, 8, G, cid, (const char*)(ws + WS_WD), (size_t)DM * DFF, (size_t)256 * DFF};
        pg8::SlotA AM{DFF}; pg8::EpiDown E{(bf16_t*)(ws + WS_Y), args.in[17], (const float*)(ws + WS_ROUTE + RT_GLIST)};
        pg8::gemm_phase<pg8::EpiDown, pg8::MoeOrder, pg8::SlotA, true, true>(F.lds, (const char*)(ws + WS_HID), DFF, S, AM, E);
#if DBL == 89
        pg8::gemm_phase<pg8::EpiDown, pg8::MoeOrder, pg8::SlotA, true, true>(F.lds, (const char*)(ws + WS_HID), DFF, S, AM, E);
#endif
    } SEAM(9);

    if (IN(10)) { moe_tables(F, tp, cb); p11_combine(F, args, cb); }
#undef IN
#undef SEAM
}

extern "C" void kernel_launch(void* const* d_in, const int* in_sizes, int n_in, void* d_out, int out_size, void* d_ws, size_t ws_size, hipStream_t stream) {
    static int grid = 0;
    if (grid == 0) {
        if (n_in != 19 || out_size != TOK2 * DM || ws_size < WS_END) { fprintf(stderr, "kernel_launch: unexpected shapes (n_in %d out %d ws %zu)\n", n_in, out_size, ws_size); grid = -1; return; }
        int dev = 0, cus = 0, per_cu = 0;
        if (hipGetDevice(&dev) != hipSuccess || hipDeviceGetAttribute(&cus, hipDeviceAttributeMultiprocessorCount, dev) != hipSuccess) { grid = -1; return; }
        if (hipFuncSetAttribute((const void*)fwd_kernel, hipFuncAttributeMaxDynamicSharedMemorySize, LDS_BYTES) != hipSuccess) { fprintf(stderr, "kernel_launch: hipFuncSetAttribute failed\n"); grid = -1; return; }
        if (hipOccupancyMaxActiveBlocksPerMultiprocessor(&per_cu, (const void*)fwd_kernel, NTHR, LDS_BYTES) != hipSuccess || per_cu < 1) { fprintf(stderr, "kernel_launch: occupancy query says %d\n", per_cu); }
        (void)hipGetLastError();
        grid = cus;
    }
    if (grid < 0) return;
    if (hipMemsetAsync((char*)d_ws + WS_CTL, 0, CTL_ZERO_BYTES, stream) != hipSuccess) return;
    Args a{};
    for (int i = 0; i < 19; ++i) a.in[i] = (const float*)d_in[i];
    a.out = (float*)d_out; a.ws = (unsigned char*)d_ws;
#if MK_N_LAUNCHES == 1
    a.ph_lo = 0; a.ph_hi = NPHASE;
    hipLaunchKernelGGL(fwd_kernel, dim3(grid), dim3(NTHR), LDS_BYTES, stream, a);
#else
    for (int p = 0; p < NPHASE; ++p) { a.ph_lo = p; a.ph_hi = p + 1; hipLaunchKernelGGL(fwd_kernel, dim3(grid), dim3(NTHR), LDS_BYTES, stream, a); }
#endif
}
```
